# Optimizing an MI355X kernel written in HIP

```python
import functools
import jax, jax.numpy as jnp
from jax import lax
import numpy as np

D_MODEL = 1024
BATCH = 4
SEQ = 8192
DEPTH = 4

GRID_W = 64
CTX_LEN = 256
N_HEADS = 8
QK_NOPE_DIM = 64
QK_ROPE_DIM = 32
QK_HEAD_DIM = QK_NOPE_DIM + QK_ROPE_DIM
ATTN_WIDTH = D_MODEL // 2
V_HEAD_DIM = ATTN_WIDTH // N_HEADS
Q_LORA_RANK = D_MODEL // 4
KV_LORA_RANK = D_MODEL // 4
ROPE_THETA = 10000.0
Q_BLOCK = 128
FOURIER_WIDTH = D_MODEL - ATTN_WIDTH
FOURIER_GROUPS = 4
FOURIER_GROUP_DIM = FOURIER_WIDTH // FOURIER_GROUPS
KV_OFFSET = Q_LORA_RANK
KPE_OFFSET = Q_LORA_RANK + KV_LORA_RANK
FOURIER_OFFSET = KPE_OFFSET + QK_ROPE_DIM
IN_WIDTH = FOURIER_OFFSET + FOURIER_WIDTH
MIX_WIDTH = ATTN_WIDTH + FOURIER_WIDTH
FFN_DIM = 2816
N_EXPERTS = 8
TOP_K = 2
MOE_FFN_DIM = 3584
MOE_BLOCK = 512
N_DENSE = (DEPTH + 1) // 2
N_MOE = DEPTH // 2
EPS = 1e-6

kernel_name = 'hymba_mla_fnet_moe_dit_trunk'


def rms_norm(x, g):
    xf = x.astype(jnp.float32)
    y = xf * lax.rsqrt(jnp.mean(xf * xf, axis=-1, keepdims=True) + EPS)
    return (y * g.astype(jnp.float32)).astype(x.dtype)


def modulate(h, shift, scale):
    return h * (1 + scale) + shift


def axial_angles(n_tokens):
    rows = n_tokens // GRID_W
    r = jnp.repeat(jnp.arange(rows, dtype=jnp.float32), GRID_W)
    col = jnp.tile(jnp.arange(GRID_W, dtype=jnp.float32), rows)
    half = QK_ROPE_DIM // 2
    inv_freq = ROPE_THETA ** (-jnp.arange(0, half, 2, dtype=jnp.float32) / half)
    return r[:, None] * inv_freq, col[:, None] * inv_freq


def rotate(x, ang):
    n = x.shape[-1] // 2
    cos = jnp.cos(ang)[None, :, None, :].astype(x.dtype)
    sin = jnp.sin(ang)[None, :, None, :].astype(x.dtype)
    x1, x2 = x[..., :n], x[..., n:]
    return jnp.concatenate([x1 * cos - x2 * sin, x1 * sin + x2 * cos], axis=-1)


def axial_rope(x, angles):
    ang_row, ang_col = angles
    half = QK_ROPE_DIM // 2
    return jnp.concatenate([rotate(x[..., :half], ang_row), rotate(x[..., half:], ang_col)], axis=-1)


def mla_queries(p, lora_norm, w_uq, qk_gain, angles):
    b, L, _ = p.shape
    q = jnp.matmul(rms_norm(p[..., :Q_LORA_RANK], lora_norm), w_uq).reshape(b, L, N_HEADS, QK_HEAD_DIM)
    q = rms_norm(q, qk_gain)
    if angles is not None:
        q = jnp.concatenate([q[..., :QK_NOPE_DIM], axial_rope(q[..., QK_NOPE_DIM:], angles)], axis=-1)
    return q


def mla_keys_values(p, lora_norm, w_ukv, qk_gain, angles):
    b, L, _ = p.shape
    c_kv = rms_norm(p[..., KV_OFFSET:KPE_OFFSET], lora_norm)
    kv = jnp.matmul(c_kv, w_ukv).reshape(b, L, N_HEADS, QK_NOPE_DIM + V_HEAD_DIM)
    k_pe = jnp.broadcast_to(p[:, :, None, KPE_OFFSET:FOURIER_OFFSET], (b, L, N_HEADS, QK_ROPE_DIM))
    k = rms_norm(jnp.concatenate([kv[..., :QK_NOPE_DIM], k_pe], axis=-1), qk_gain)
    if angles is not None:
        k = jnp.concatenate([k[..., :QK_NOPE_DIM], axial_rope(k[..., QK_NOPE_DIM:], angles)], axis=-1)
    return k, kv[..., QK_NOPE_DIM:]


def attend(q, k, v):
    s = jnp.einsum('bqhd,bkhd->bhqk', q, k, preferred_element_type=jnp.float32) * (QK_HEAD_DIM ** -0.5)
    p = jax.nn.softmax(s, axis=-1).astype(v.dtype)
    return jnp.einsum('bhqk,bkhd->bqhd', p, v)


def latent_attention(q, k, v):
    b, L, h, dk = q.shape
    nblk = L // Q_BLOCK
    qb = q.reshape(b, nblk, Q_BLOCK, h, dk).transpose(1, 0, 2, 3, 4)
    ob = lax.map(lambda qi: attend(qi, k, v), qb)
    return ob.transpose(1, 0, 2, 3, 4).reshape(b, L, h * v.shape[-1])


def fourier_mix(f):
    b, L, _ = f.shape
    fg = f.reshape(b, L, FOURIER_GROUPS, FOURIER_GROUP_DIM).astype(jnp.float32)
    out = jnp.fft.fft2(fg, axes=(1, 3), norm='ortho').real
    return out.reshape(b, L, FOURIER_WIDTH).astype(f.dtype)


def merge_heads(attn, four, g_attn, g_four, w_out):
    return jnp.matmul(jnp.concatenate([rms_norm(attn, g_attn), rms_norm(four, g_four)], axis=-1), w_out)


def swiglu(h, wg, wu, wd):
    return jnp.matmul(jax.nn.silu(jnp.matmul(h, wg)) * jnp.matmul(h, wu), wd)


def moe_swiglu(h, w_router, w_gate, w_up, w_down):
    b, L, d = h.shape
    xs = h.reshape(b * L, d)
    n_assign = b * L * TOP_K
    logits = jnp.matmul(xs, w_router).astype(jnp.float32)
    top_logit, top_idx = lax.top_k(logits, TOP_K)
    top_w = jax.nn.softmax(top_logit, axis=-1)
    exp_flat = top_idx.reshape(n_assign)
    tok_flat = jnp.arange(n_assign, dtype=jnp.int32) // TOP_K
    w_flat = top_w.reshape(n_assign)
    order = jnp.argsort(exp_flat)
    exp_sorted = exp_flat[order]
    counts = jnp.bincount(exp_flat, length=N_EXPERTS)
    starts = jnp.cumsum(counts) - counts
    padded = (counts + MOE_BLOCK - 1) // MOE_BLOCK * MOE_BLOCK
    pad_ends = jnp.cumsum(padded)
    pad_starts = pad_ends - padded
    dest = pad_starts[exp_sorted] + jnp.arange(n_assign, dtype=jnp.int32) - starts[exp_sorted]
    n_blocks = (n_assign + N_EXPERTS * (MOE_BLOCK - 1) + MOE_BLOCK - 1) // MOE_BLOCK
    n_rows = n_blocks * MOE_BLOCK
    row_tok = jnp.zeros((n_rows,), jnp.int32).at[dest].set(tok_flat[order])
    row_w = jnp.zeros((n_rows,), jnp.float32).at[dest].set(w_flat[order])
    block_exp = jnp.minimum(
        jnp.searchsorted(pad_ends, jnp.arange(n_blocks, dtype=jnp.int32) * MOE_BLOCK, side='right'),
        N_EXPERTS - 1)

    def expert_block(args):
        tok, e = args
        return swiglu(xs[tok], w_gate[e], w_up[e], w_down[e])

    yb = lax.map(expert_block, (row_tok.reshape(n_blocks, MOE_BLOCK), block_exp))
    y = jnp.zeros_like(xs).at[row_tok].add(yb.reshape(n_rows, d) * row_w[:, None].astype(xs.dtype))
    return y.reshape(b, L, d)


def setup_inputs(seed: int = 0) -> dict:
    key = jax.random.key(seed)
    ks = jax.random.split(key, 25)
    f32 = jnp.float32

    def dense(k, shape, fan_in, gain=1.0):
        return jax.random.normal(k, shape, f32) * (gain * fan_in ** -0.5)

    def gain_vec(k, shape):
        return 1.0 + 0.02 * jax.random.normal(k, shape, f32)

    return {
        'x': jax.random.normal(ks[0], (BATCH, SEQ, D_MODEL), f32),
        'c': jax.random.normal(ks[1], (BATCH, D_MODEL), f32),
        'ctx': jax.random.normal(ks[2], (BATCH, CTX_LEN, D_MODEL), f32),
        'c_ctx': jax.random.normal(ks[3], (D_MODEL,), f32),
        'w_ada': dense(ks[4], (DEPTH, D_MODEL, 6 * D_MODEL), D_MODEL, 0.5),
        'b_ada': 0.02 * jax.random.normal(ks[5], (DEPTH, 6 * D_MODEL), f32),
        'norm1': gain_vec(ks[6], (DEPTH, D_MODEL)),
        'w_in': dense(ks[7], (DEPTH, D_MODEL, IN_WIDTH), D_MODEL),
        'q_lora_norm': gain_vec(ks[8], (DEPTH, Q_LORA_RANK)),
        'kv_lora_norm': gain_vec(ks[9], (DEPTH, KV_LORA_RANK)),
        'w_uq': dense(ks[10], (DEPTH, Q_LORA_RANK, N_HEADS * QK_HEAD_DIM), Q_LORA_RANK),
        'w_ukv': dense(ks[11], (DEPTH, KV_LORA_RANK, N_HEADS * (QK_NOPE_DIM + V_HEAD_DIM)), KV_LORA_RANK),
        'q_norm': gain_vec(ks[12], (DEPTH, QK_HEAD_DIM)),
        'k_norm': gain_vec(ks[13], (DEPTH, QK_HEAD_DIM)),
        'out_norm_attn': gain_vec(ks[14], (DEPTH, ATTN_WIDTH)),
        'out_norm_fourier': gain_vec(ks[15], (DEPTH, FOURIER_WIDTH)),
        'w_out': dense(ks[16], (DEPTH, MIX_WIDTH, D_MODEL), MIX_WIDTH),
        'norm2': gain_vec(ks[17], (DEPTH, D_MODEL)),
        'w_ffn_gate': dense(ks[18], (N_DENSE, D_MODEL, FFN_DIM), D_MODEL),
        'w_ffn_up': dense(ks[19], (N_DENSE, D_MODEL, FFN_DIM), D_MODEL),
        'w_ffn_down': dense(ks[20], (N_DENSE, FFN_DIM, D_MODEL), FFN_DIM),
        'w_router': dense(ks[21], (N_MOE, D_MODEL, N_EXPERTS), D_MODEL),
        'w_moe_gate': dense(ks[22], (N_MOE, N_EXPERTS, D_MODEL, MOE_FFN_DIM), D_MODEL),
        'w_moe_up': dense(ks[23], (N_MOE, N_EXPERTS, D_MODEL, MOE_FFN_DIM), D_MODEL),
        'w_moe_down': dense(ks[24], (N_MOE, N_EXPERTS, MOE_FFN_DIM, D_MODEL), MOE_FFN_DIM),
    }


def reference(x, c, ctx, c_ctx, w_ada, b_ada, norm1, w_in, q_lora_norm, kv_lora_norm, w_uq, w_ukv,
              q_norm, k_norm, out_norm_attn, out_norm_fourier, w_out, norm2, w_ffn_gate, w_ffn_up,
              w_ffn_down, w_router, w_moe_gate, w_moe_up, w_moe_down):
    angles = axial_angles(x.shape[1])
    silu_c = jax.nn.silu(c)
    silu_cc = jax.nn.silu(c_ctx)
    for layer in range(DEPTH):
        update_ctx = layer < DEPTH - 1
        mod = jnp.matmul(silu_c, w_ada[layer]) + b_ada[layer]
        mod_c = jnp.matmul(silu_cc, w_ada[layer]) + b_ada[layer]
        shift1, scale1, gate1, shift2, scale2, gate2 = jnp.split(mod[:, None, :], 6, axis=-1)
        cshift1, cscale1, cgate1, cshift2, cscale2, cgate2 = jnp.split(mod_c, 6, axis=-1)

        h = modulate(rms_norm(x, norm1[layer]), shift1, scale1)
        hc = modulate(rms_norm(ctx, norm1[layer]), cshift1, cscale1)
        p = jnp.matmul(h, w_in[layer])
        pc = jnp.matmul(hc, w_in[layer])
        q = mla_queries(p, q_lora_norm[layer], w_uq[layer], q_norm[layer], angles)
        k, v = mla_keys_values(p, kv_lora_norm[layer], w_ukv[layer], k_norm[layer], angles)
        kc, vc = mla_keys_values(pc, kv_lora_norm[layer], w_ukv[layer], k_norm[layer], None)
        attn = latent_attention(q, jnp.concatenate([k, kc], axis=1), jnp.concatenate([v, vc], axis=1))
        four = fourier_mix(p[..., FOURIER_OFFSET:])
        x = x + gate1 * merge_heads(attn, four, out_norm_attn[layer], out_norm_fourier[layer], w_out[layer])
        if update_ctx:
            qc = mla_queries(pc, q_lora_norm[layer], w_uq[layer], q_norm[layer], None)
            attn_c = attend(qc, kc, vc).reshape(pc.shape[0], pc.shape[1], ATTN_WIDTH)
            four_c = fourier_mix(pc[..., FOURIER_OFFSET:])
            ctx = ctx + cgate1 * merge_heads(attn_c, four_c, out_norm_attn[layer], out_norm_fourier[layer],
                                             w_out[layer])

        if layer % 2 == 0:
            ffn = functools.partial(swiglu, wg=w_ffn_gate[layer // 2], wu=w_ffn_up[layer // 2],
                                    wd=w_ffn_down[layer // 2])
        else:
            ffn = functools.partial(moe_swiglu, w_router=w_router[layer // 2], w_gate=w_moe_gate[layer // 2],
                                    w_up=w_moe_up[layer // 2], w_down=w_moe_down[layer // 2])
        x = x + gate2 * ffn(modulate(rms_norm(x, norm2[layer]), shift2, scale2))
        if update_ctx:
            ctx = ctx + cgate2 * ffn(modulate(rms_norm(ctx, norm2[layer]), cshift2, cscale2))
    return x
```

```cpp
#include <hip/hip_runtime.h>
#include <cstdio>
#include <cstdint>

#define GAS __attribute__((address_space(1)))
#define LAS __attribute__((address_space(3)))
typedef unsigned short bf16_t;
typedef short bf16x8 __attribute__((ext_vector_type(8)));
typedef short s16x4 __attribute__((ext_vector_type(4)));
typedef float f32x2 __attribute__((ext_vector_type(2)));
typedef float f32x4 __attribute__((ext_vector_type(4)));
typedef float f32x16 __attribute__((ext_vector_type(16)));
typedef unsigned u32x2 __attribute__((ext_vector_type(2)));
typedef unsigned u32x4 __attribute__((ext_vector_type(4)));

constexpr int NB = 4, SEQ = 8192, CTXL = 256, SB = SEQ + CTXL, TT = NB * SB;
constexpr int DM = 1024, INW = 1056, NH = 8, QKD = 96, VD = 64, AW = 512, FW = 512;
constexpr int FFN = 2816, NE = 8, MFF = 3584, DEPTH = 4;
constexpr int MT = TT / 256;
constexpr float EPS = 1e-6f;
constexpr float QSCALE = 0.10206207261596577f * 1.4426950408889634f;

constexpr size_t MiB = 1u << 20;
constexpr size_t WS_CTL = 0, CTL_ZERO_BYTES = 16384;
constexpr size_t WS_MOD = 1 * MiB;
constexpr size_t WS_META = 2 * MiB;
constexpr size_t WS_CTXS = 4 * MiB;
constexpr size_t WS_SCL = 8 * MiB, SCL_ZERO_BYTES = 576 * 1024;
constexpr size_t SCL_SWM = 0, SCL_SWD = 2 * 8 * 7168 * 4, SCL_SWO = SCL_SWD + 2 * 5632 * 4, SCL_SWI = SCL_SWO + 4 * 1024 * 4;
constexpr size_t SCL_END = SCL_SWI + 4 * 1280 * 4;
static_assert(SCL_END <= SCL_ZERO_BYTES, "scale map");
constexpr size_t WS_WIN = 16 * MiB;
constexpr size_t WS_WUQ = 26 * MiB;
constexpr size_t WS_WUKV = 28 * MiB;
constexpr size_t WS_WOUT = 30 * MiB;
constexpr size_t WS_WGU = 38 * MiB;
constexpr size_t WS_WD = 60 * MiB;
constexpr size_t WS_MGU = 72 * MiB;
constexpr size_t WS_MD = 184 * MiB;
constexpr size_t WS_H = 240 * MiB;
constexpr size_t WS_R = 306 * MiB;
constexpr size_t WS_P = WS_R;
constexpr size_t WS_QRAW = WS_R + 69 * MiB;
constexpr size_t WS_KVRAW = WS_R + 119 * MiB;
constexpr size_t WS_Q = WS_R + 185 * MiB;
constexpr size_t WS_K = WS_R + 235 * MiB;
constexpr size_t WS_V = WS_R + 285 * MiB;
constexpr size_t WS_ATT = WS_R + 318 * MiB;
constexpr size_t WS_FOUR = WS_R + 351 * MiB;
constexpr size_t WS_MID = WS_R + 384 * MiB;
constexpr size_t WS_HID = WS_R;
constexpr size_t WS_AMOE = WS_R;
constexpr size_t WS_HMOE = WS_R + 68 * MiB;
constexpr size_t WS_Y = WS_R + 306 * MiB;
constexpr size_t WS_CPART = WS_R + 448 * MiB;
constexpr size_t WS_XB = WS_R + 496 * MiB;
constexpr size_t WS_XCB = WS_XB + 64 * MiB;
constexpr size_t WS_END = WS_XCB + 2 * MiB;
static_assert((size_t)TT * INW * 2 <= 69 * MiB && (size_t)TT * 768 * 2 <= 50 * MiB && (size_t)TT * 1024 * 2 <= 66 * MiB && (size_t)TT * 512 * 2 <= 33 * MiB, "activation sizes");
static_assert(WS_MID + 64 * MiB <= WS_END && (size_t)TT * FFN * 2 <= 182 * MiB, "map");
constexpr size_t MT_RE = 0, MT_RW = 270336 * 1, MT_LR = 270336 * 2, MT_TS = 270336 * 3, MT_BC = 270336 * 4, MT_TE = MT_BC + 8192, MT_NT = MT_TE + 2048;
constexpr size_t MT_SA = 1310720, MT_SWM = 1605632, MT_SH = 1835008, MT_SWD = 1970176;
static_assert(MT_NT + 64 <= MT_SA && MT_SA + 69632 * 4 <= MT_SWM && MT_SWM + 8 * 7168 * 4 <= MT_SH && MT_SH + TT * 4 <= MT_SWD && MT_SWD + 2 * 5632 * 4 <= 2 * MiB, "meta map");
constexpr int MOE_ROWS_MAX = 69632, MOE_MAX_TILES = 272;
static_assert(WS_HMOE + (size_t)MOE_ROWS_MAX * MFF <= WS_Y && WS_Y + (size_t)MOE_ROWS_MAX * DM * 2 <= WS_END, "moe map");
constexpr float HID_SCALE = 8.f, WD_SCALE = 64.f, DOWN_OSCALE = 1.f / 512.f;

constexpr int RING_BYTES = 131072, MISC_OFF = RING_BYTES, LDS_BYTES = 147456;

__device__ __forceinline__ unsigned cvt_pk_bf16(float lo, float hi) { unsigned r; asm volatile("v_cvt_pk_bf16_f32 %0, %1, %2" : "=v"(r) : "v"(lo), "v"(hi)); return r; }
__device__ __forceinline__ float bflo(unsigned u) { return __uint_as_float(u << 16); }
__device__ __forceinline__ float bfhi(unsigned u) { return __uint_as_float(u & 0xffff0000u); }
__device__ __forceinline__ float wave_sum(float v) {
#pragma unroll
    for (int o = 1; o < 64; o <<= 1) v += __shfl_xor(v, o);
    return v;
}
#define LDS_WAIT() asm volatile("s_waitcnt lgkmcnt(0)" ::: "memory")
#define VM_WAIT() asm volatile("s_waitcnt vmcnt(0)" ::: "memory")
__device__ __forceinline__ int otid() { int t = threadIdx.x; asm volatile("" : "+v"(t)); return t; }
namespace pg8 {
#define PG8_LAS __attribute__((address_space(3)))
#ifndef T_WGM
#define T_WGM 8
#endif
#ifndef T_XCD
#define T_XCD 1
#endif
constexpr int BM = 256, BK = 64, HALF = 128, HTB = HALF * BK * 2  , STAGE_BYTES = 8 * HTB, NXCD = 8, WGM = T_WGM;
__host__ __device__ __forceinline__ int lds_byte(int r, int c) { const int st = (r >> 4) * 2 + (c >> 5), rr = r & 15, cc = c & 31, ob = rr * 64 + cc * 2; return st * 1024 + (ob ^ (((ob >> 9) & 1) << 5)); }
__host__ __device__ __forceinline__ void stage_rc(int b, int& R, int& C) { const int st = b / 1024, sb = b % 1024, swz = sb ^ (((sb >> 9) & 1) << 5); R = (st >> 1) * 16 + swz / 64; C = (st & 1) * 32 + (swz % 64) / 2; }
__host__ __device__ __forceinline__ int perm32(int rho) { const int n = rho >> 4, i = rho & 15; return 8 * (i >> 2) + 4 * n + (i & 3); }

typedef int i32x4 __attribute__((ext_vector_type(4)));
typedef int i32x8 __attribute__((ext_vector_type(8)));
template <int MODE> struct AccOf { typedef f32x4 T; };
template <> struct AccOf<1> { typedef i32x4 T; };
template <int MODE> __device__ __forceinline__ typename AccOf<MODE>::T mma16(bf16x8 a, bf16x8 b, typename AccOf<MODE>::T c) {
    if constexpr (MODE == 1) return __builtin_amdgcn_mfma_i32_16x16x64_i8(__builtin_bit_cast(i32x4, a), __builtin_bit_cast(i32x4, b), c, 0, 0, 0);
    else return __builtin_amdgcn_mfma_f32_16x16x32_bf16(a, b, c, 0, 0, 0);
}
__device__ __forceinline__ f32x4 mma_f8(bf16x8 a0, bf16x8 a1, bf16x8 b0, bf16x8 b1, f32x4 c) {
    const i32x4 x0 = __builtin_bit_cast(i32x4, a0), x1 = __builtin_bit_cast(i32x4, a1), y0 = __builtin_bit_cast(i32x4, b0), y1 = __builtin_bit_cast(i32x4, b1);
    const i32x8 A = {x0[0], x0[1], x0[2], x0[3], x1[0], x1[1], x1[2], x1[3]}, B = {y0[0], y0[1], y0[2], y0[3], y1[0], y1[1], y1[2], y1[3]};
    return __builtin_amdgcn_mfma_scale_f32_16x16x128_f8f6f4(A, B, c, 0, 0, 0, 0x7F7F7F7F, 0, 0x7F7F7F7F);
}
__device__ __forceinline__ i32x8 cat8(bf16x8 lo, bf16x8 hi) { const i32x4 a = __builtin_bit_cast(i32x4, lo), b = __builtin_bit_cast(i32x4, hi); return __builtin_shufflevector(a, b, 0, 1, 2, 3, 4, 5, 6, 7); }
struct Unit { const char* A; const char* B; int pm, pn, B_scale_off, par; };

__device__ __forceinline__ bool tile_order(int i, int G, int c, int nM, int nN, int& tm, int& tn) {
    const int nwg = nM * nN; const long L = (long)i * G + c; if (L >= nwg) return false;
    int wgid = (int)L; if (T_XCD) { const int q = nwg / NXCD, r = nwg % NXCD, xcd = wgid % NXCD, off = wgid / NXCD; wgid = (xcd < r ? xcd * (q + 1) : r * (q + 1) + (xcd - r) * q) + off; }
    const int nig = WGM * nN, gid = wgid / nig, fm = gid * WGM, gsz = (nM - fm) < WGM ? (nM - fm) : WGM;
    tm = fm + ((wgid % nig) % gsz); tn = (wgid % nig) / gsz; return true;
}
struct DenseOrder {
    const char* A; const char* B; size_t a_tile_bytes, b_tile_bytes; int nM, nN, G, c, skipctx;
    __device__ __forceinline__ bool next(int i, Unit& u) const {
        int tm, tn; if (!tile_order(i, G, c, nM, nN, tm, tn)) return false;
        const int pm = skipctx ? tm + (tm >> 5) : tm; u.pm = pm; u.pn = tn; u.B_scale_off = 0; u.A = A + (size_t)pm * a_tile_bytes; u.B = B + (size_t)tn * b_tile_bytes; return true;
    }
};
struct CtxOrder {
    const char* A; const char* B; size_t a_tile_bytes, b_tile_bytes; int G, c;
    __device__ __forceinline__ bool next(int i, Unit& u) const {
        const int L = i * G + c; if (L >= 16) return false;
        const int pm = (L >> 2) * 33 + 32; u.pm = pm; u.pn = L & 3; u.B_scale_off = 0; u.A = A + (size_t)pm * a_tile_bytes; u.B = B + (size_t)(L & 3) * b_tile_bytes; return true;
    }
};
struct MoeOrder {
    const char* A; const char* B; size_t a_tile_bytes, b_tile_bytes, b_exp_bytes; const int* tile_exp; int tile0, nM, nN, G, c, b_exp_rows;
    __device__ __forceinline__ bool next(int i, Unit& u) const {
        int tm, tn; if (!tile_order(i, G, c, nM, nN, tm, tn)) return false;
        const int e = __builtin_amdgcn_readfirstlane(tile_exp[tile0 + tm]);
        u.pm = tm; u.pn = tn; u.B_scale_off = e * b_exp_rows; u.A = A + (size_t)tm * a_tile_bytes; u.B = B + (size_t)e * b_exp_bytes + (size_t)tn * b_tile_bytes; return true;
    }
};

template <int MODE_> struct EpiBf16 {
    static constexpr bool PERM = true, AFTER_DRAIN = false, PREFETCH = false; static constexpr int MODE = MODE_;
    bf16_t* O; const float* sa; const float* sw; int ldc, ncols;
    __device__ __forceinline__ void operator()(const typename AccOf<MODE_>::T (&acc)[2][2][4][2], const Unit& u, int wr, int wc, int fr, int fq) const {
        const int row0 = u.pm * BM + wr * 64 + fr, col0 = u.pn * BM + wc * 32 + 8 * fq;
        f32x4 ws_[2][2];
        if constexpr (MODE_ == 1) {
#pragma unroll
            for (int bj = 0; bj < 2; ++bj) { ws_[bj][0] = *(const f32x4*)(sw + col0 + bj * HALF) * (1.f / 127.f); ws_[bj][1] = *(const f32x4*)(sw + col0 + bj * HALF + 4) * (1.f / 127.f); } }
#pragma unroll
        for (int ai = 0; ai < 2; ++ai)
#pragma unroll
            for (int m = 0; m < 4; ++m) { bf16_t* rowp = O + (size_t)(row0 + ai * HALF + m * 16) * ldc + col0; float rs = 1.f; if constexpr (MODE_ == 1) rs = sa[row0 + ai * HALF + m * 16];
#pragma unroll
                for (int bj = 0; bj < 2; ++bj) { if (col0 + bj * HALF < ncols) { f32x4 v0, v1; if constexpr (MODE_ == 1) { v0 = __builtin_convertvector(acc[ai][bj][m][0], f32x4) * (ws_[bj][0] * rs); v1 = __builtin_convertvector(acc[ai][bj][m][1], f32x4) * (ws_[bj][1] * rs); } else { v0 = acc[ai][bj][m][0]; v1 = acc[ai][bj][m][1]; }
                    u32x4 w; w.x = cvt_pk_bf16(v0[0], v0[1]); w.y = cvt_pk_bf16(v0[2], v0[3]); w.z = cvt_pk_bf16(v1[0], v1[1]); w.w = cvt_pk_bf16(v1[2], v1[3]);
                    *(u32x4*)(rowp + bj * HALF) = w; } } }
    }
};
__device__ __forceinline__ float silu_mul(float g, float u) { return g * u * __builtin_amdgcn_rcpf(1.f + __builtin_amdgcn_exp2f(-1.4426950408889634f * g)); }
template <int MODE_, bool SRC_F32> struct EpiResid {
    static constexpr bool PERM = false, AFTER_DRAIN = false, PREFETCH = false; static constexpr int MODE = MODE_;
    const void* lat_in; bf16_t* lat_out; const void* ctx_in; bf16_t* ctx_out; const float* gate; const float* sa; const float* sw; float oscale;
    __device__ __forceinline__ void operator()(const typename AccOf<MODE_>::T (&acc)[2][2][4][2], const Unit& u, int wr, int wc, int fr, int fq) const {
        const int b = u.pm / 33, j = u.pm % 33; const unsigned char* src; bf16_t* dst; int mr;
        if (j < 32) { const size_t off = ((size_t)b * SEQ + (size_t)j * 256) * DM; src = (const unsigned char*)lat_in + off * (SRC_F32 ? 4 : 2); dst = lat_out + off; mr = b; }
        else { const size_t off = (size_t)b * CTXL * DM; src = (const unsigned char*)ctx_in + off * (SRC_F32 ? 4 : 2); dst = ctx_out + off; mr = 4; }
        const int col0 = u.pn * BM + wc * 32 + 4 * fq; const float* gp = gate + (size_t)mr * 6144 + col0;
        f32x4 gv[2][2];
#pragma unroll
        for (int bj = 0; bj < 2; ++bj)
#pragma unroll
            for (int n = 0; n < 2; ++n) { gv[bj][n] = *(const f32x4*)(gp + bj * HALF + n * 16) * oscale; if constexpr (MODE_ == 1) gv[bj][n] = gv[bj][n] * *(const f32x4*)(sw + col0 + bj * HALF + n * 16); }
#pragma unroll
        for (int ai = 0; ai < 2; ++ai)
#pragma unroll
            for (int m = 0; m < 4; ++m) { const int rl = wr * 64 + fr + ai * HALF + m * 16; const size_t ro = (size_t)rl * DM + col0;
                float rs = 1.f; if constexpr (MODE_ == 1) rs = sa[u.pm * BM + rl];
#pragma unroll
                for (int bj = 0; bj < 2; ++bj)
#pragma unroll
                    for (int n = 0; n < 2; ++n) { const size_t e = ro + bj * HALF + n * 16; f32x4 x;
                        if constexpr (SRC_F32) x = *(const f32x4*)(src + e * 4); else { const u32x2 xb = *(const u32x2*)(src + e * 2); x = (f32x4){__uint_as_float(xb.x << 16), __uint_as_float(xb.x & 0xffff0000u), __uint_as_float(xb.y << 16), __uint_as_float(xb.y & 0xffff0000u)}; }
                        if constexpr (MODE_ == 1) x = x + (gv[bj][n] * rs) * __builtin_convertvector(acc[ai][bj][m][n], f32x4); else x = x + gv[bj][n] * acc[ai][bj][m][n];
                        *(u32x2*)(dst + e) = (u32x2){cvt_pk_bf16(x[0], x[1]), cvt_pk_bf16(x[2], x[3])}; } }
    }
};


__device__ __forceinline__ float clamp448(float x) { return fminf(fmaxf(x, -448.f), 448.f); }
template <bool F8OUT> struct EpiSwigluI8 {
    static constexpr bool PERM = true, AFTER_DRAIN = false, PREFETCH = true; static constexpr int MODE = 1;
    bf16_t* O; int ldc; const float* sa; const float* sw; PG8_LAS unsigned char* l;
    __device__ __forceinline__ void prefetch(const Unit& u, int wid, int lane) const {
        const float* src = (wid < 4) ? sa + (size_t)u.pm * BM + wid * 64 : sw + u.B_scale_off + u.pn * BM + (wid - 4) * 64;
        __builtin_amdgcn_global_load_lds((const unsigned*)(src + lane), (PG8_LAS unsigned*)(l + MISC_OFF + 4096 + u.par * 2048 + wid * 256), 4, 0, 0); }
    __device__ __forceinline__ void operator()(const i32x4 (&acc)[2][2][4][2], const Unit& u, int wr, int wc, int fr, int fq) const {
        const int row0 = u.pm * BM + wr * 64 + fr, col0 = u.pn * HALF + wc * 32 + 8 * fq;
        const PG8_LAS float* ls = (const PG8_LAS float*)(l + MISC_OFF + 4096 + u.par * 2048); const PG8_LAS float* swp = ls + 256 + wc * 32 + 8 * fq;
        const f32x4 wg0 = *(const PG8_LAS f32x4*)swp, wg1 = *(const PG8_LAS f32x4*)(swp + 4), wu0 = *(const PG8_LAS f32x4*)(swp + HALF), wu1 = *(const PG8_LAS f32x4*)(swp + HALF + 4);
#pragma unroll
        for (int ai = 0; ai < 2; ++ai)
#pragma unroll
            for (int m = 0; m < 4; ++m) { const int row = row0 + ai * HALF + m * 16; bf16_t* rowp = O + (size_t)row * ldc + col0; const float s = ls[wr * 64 + fr + ai * HALF + m * 16] * (1.f / 127.f);
                const i32x4 g0i = acc[ai][0][m][0], g1i = acc[ai][0][m][1], u0i = acc[ai][1][m][0], u1i = acc[ai][1][m][1];
                if constexpr (F8OUT) {
                    const f32x4 G0 = __builtin_convertvector(g0i, f32x4) * wg0, G1 = __builtin_convertvector(g1i, f32x4) * wg1, U0 = __builtin_convertvector(u0i, f32x4) * wu0, U1 = __builtin_convertvector(u1i, f32x4) * wu1;
                    const float c1 = -1.4426950408889634f * s, c2 = HID_SCALE * s * s;
#define SW8(G_, U_, i_) clamp448((G_[i_] * U_[i_]) * (c2 * __builtin_amdgcn_rcpf(1.f + __builtin_amdgcn_exp2f(G_[i_] * c1))))
                    int w0 = 0, w1 = 0;
                    w0 = __builtin_amdgcn_cvt_pk_fp8_f32(SW8(G0, U0, 0), SW8(G0, U0, 1), w0, false); w0 = __builtin_amdgcn_cvt_pk_fp8_f32(SW8(G0, U0, 2), SW8(G0, U0, 3), w0, true);
                    w1 = __builtin_amdgcn_cvt_pk_fp8_f32(SW8(G1, U1, 0), SW8(G1, U1, 1), w1, false); w1 = __builtin_amdgcn_cvt_pk_fp8_f32(SW8(G1, U1, 2), SW8(G1, U1, 3), w1, true);
#undef SW8
                    *(u32x2*)((unsigned char*)O + (size_t)row * ldc + col0) = (u32x2){(unsigned)w0, (unsigned)w1}; }
                else { const f32x4 g0 = __builtin_convertvector(g0i, f32x4) * (wg0 * s), g1 = __builtin_convertvector(g1i, f32x4) * (wg1 * s), u0 = __builtin_convertvector(u0i, f32x4) * (wu0 * s), u1 = __builtin_convertvector(u1i, f32x4) * (wu1 * s);
                    u32x4 w; w.x = cvt_pk_bf16(silu_mul(g0[0], u0[0]), silu_mul(g0[1], u0[1])); w.y = cvt_pk_bf16(silu_mul(g0[2], u0[2]), silu_mul(g0[3], u0[3]));
                    w.z = cvt_pk_bf16(silu_mul(g1[0], u1[0]), silu_mul(g1[1], u1[1])); w.w = cvt_pk_bf16(silu_mul(g1[2], u1[2]), silu_mul(g1[3], u1[3]));
                    *(u32x4*)rowp = w; } }
    }
};

struct EpiNullI8 {
    static constexpr bool PERM = true, AFTER_DRAIN = false, PREFETCH = false; static constexpr int MODE = 1;
    unsigned* O;
    __device__ __forceinline__ void operator()(const i32x4 (&acc)[2][2][4][2], const Unit& u, int wr, int wc, int fr, int fq) const {
        i32x4 s = acc[0][0][0][0];
#pragma unroll
        for (int ai = 0; ai < 2; ++ai)
#pragma unroll
            for (int bj = 0; bj < 2; ++bj)
#pragma unroll
                for (int m = 0; m < 4; ++m)
#pragma unroll
                    for (int n = 0; n < 2; ++n) s ^= acc[ai][bj][m][n];
        *(i32x4*)(O + ((size_t)(u.pm * 32 + u.pn) * 512 + threadIdx.x) * 4) = s;
    }
};

template <int MODE_> struct EpiCtxPart {
    static constexpr bool PERM = false, AFTER_DRAIN = false, PREFETCH = false; static constexpr int MODE = MODE_;
    float* part; const float* gate; const float* sa; const float* sw; float oscale; int pad_;
    __device__ __forceinline__ void operator()(const typename AccOf<MODE_>::T (&acc)[2][2][4][2], const Unit& u, int wr, int wc, int fr, int fq) const {
        const int b = u.pm / 33; float* dst = part + (size_t)b * CTXL * DM;
        const int col0 = u.pn * BM + wc * 32 + 4 * fq; const float* gp = gate + (size_t)4 * 6144 + col0;
        f32x4 gv[2][2];
#pragma unroll
        for (int bj = 0; bj < 2; ++bj)
#pragma unroll
            for (int n = 0; n < 2; ++n) { gv[bj][n] = *(const f32x4*)(gp + bj * HALF + n * 16) * oscale; if constexpr (MODE_ == 1) gv[bj][n] = gv[bj][n] * *(const f32x4*)(sw + col0 + bj * HALF + n * 16); }
#pragma unroll
        for (int ai = 0; ai < 2; ++ai)
#pragma unroll
            for (int m = 0; m < 4; ++m) { const int rl = wr * 64 + fr + ai * HALF + m * 16; const size_t ro = (size_t)rl * DM + col0; float rs = 1.f; if constexpr (MODE_ == 1) rs = sa[u.pm * BM + rl];
#pragma unroll
                for (int bj = 0; bj < 2; ++bj)
#pragma unroll
                    for (int n = 0; n < 2; ++n) { if constexpr (MODE_ == 1) *(f32x4*)(dst + ro + bj * HALF + n * 16) = (gv[bj][n] * rs) * __builtin_convertvector(acc[ai][bj][m][n], f32x4); else *(f32x4*)(dst + ro + bj * HALF + n * 16) = gv[bj][n] * acc[ai][bj][m][n]; } }
    }
};
template <class Epi, class Sched, bool ALIGN_EPI = false, bool SP2 = false>
__device__ __forceinline__ void gemm_phase(PG8_LAS unsigned char* lds, const int K, const int lda, const int ldb, const Sched S, const Epi E) {
    const int tid = otid(), wid = __builtin_amdgcn_readfirstlane(tid >> 6), lane = tid & 63, wr = wid >> 2, wc = wid & 3, fr = lane & 15, fq = lane >> 4;
    const int nt = K / BK;
    unsigned voffA[2], voffB[2];
#pragma unroll
    for (int i = 0; i < 2; ++i) { int R, C; stage_rc(tid * 16 + i * 8192, R, C); const int Rb = Epi::PERM ? ((R & ~31) + perm32(R & 31)) : R;
        voffA[i] = (unsigned)(R * lda + C) * 2u; voffB[i] = (unsigned)(Rb * ldb + C) * 2u; }
    const size_t kstep = (size_t)(BK * 2);
    const size_t hstepA = (size_t)HALF * lda * 2, hstepB = (size_t)HALF * ldb * 2;
    const unsigned ldsw = (unsigned)wid * 1024u;
    const int aoff = lds_byte(wr * 64 + fr, fq * 8), boff = lds_byte(wc * 32 + fr, fq * 8);
#define PG8_SA(b, h) (((b) * 2 + (h)) * HTB)
#define PG8_SB(b, h) ((4 + (b) * 2 + (h)) * HTB)
#define PG8_STAGE(bufoff, gbase, voff) do { _Pragma("unroll") for (int _i = 0; _i < 2; ++_i) \
        __builtin_amdgcn_global_load_lds((const unsigned*)((const char*)(gbase) + (voff)[_i]), (PG8_LAS unsigned*)(lds + (bufoff) + ldsw + _i * 8192), 16, 0, 0); } while (0)
#define PG8_LDA(dst, b, h) do { _Pragma("unroll") for (int m = 0; m < 4; ++m) { const bf16x8 lo_ = *(const PG8_LAS bf16x8*)(lds + PG8_SA(b, h) + aoff + m * 2048), hi_ = *(const PG8_LAS bf16x8*)(lds + PG8_SA(b, h) + aoff + m * 2048 + 1024); \
        if constexpr (Epi::MODE == 2) dst##8[m] = cat8(lo_, hi_); else { dst[m][0] = lo_; dst[m][1] = hi_; } } } while (0)
#define PG8_LDB(dst, b, h) do { _Pragma("unroll") for (int n = 0; n < 2; ++n) { const bf16x8 lo_ = *(const PG8_LAS bf16x8*)(lds + PG8_SB(b, h) + boff + n * 2048), hi_ = *(const PG8_LAS bf16x8*)(lds + PG8_SB(b, h) + boff + n * 2048 + 1024); \
        if constexpr (Epi::MODE == 2) dst##8[n] = cat8(lo_, hi_); else { dst[n][0] = lo_; dst[n][1] = hi_; } } } while (0)
#define PG8_MMA(ai, bj, At, Bt) do { __builtin_amdgcn_s_setprio(1); _Pragma("unroll") for (int m = 0; m < 4; ++m) _Pragma("unroll") for (int n = 0; n < 2; ++n) { \
        if constexpr (Epi::MODE == 2) asm volatile("v_mfma_f32_16x16x128_f8f6f4 %0, %1, %2, %0" : "+v"(acc[ai][bj][m][n]) : "v"(Bt##8[n]), "v"(At##8[m]));   \
        else { _Pragma("unroll") for (int k = 0; k < 2; ++k) acc[ai][bj][m][n] = mma16<Epi::MODE>(Bt[n][k], At[m][k], acc[ai][bj][m][n]); } } __builtin_amdgcn_s_setprio(0); } while (0)
#define PG8_WAIT_V(n) asm volatile("s_waitcnt vmcnt(" #n ")" ::: "memory")
#define PG8_WAIT_L(n) asm volatile("s_waitcnt lgkmcnt(" #n ")" ::: "memory")
#define PG8_BAR __builtin_amdgcn_s_barrier()
#define PG8_SCHED __builtin_amdgcn_sched_barrier(0)
    Unit cur, nxt; int ui = 0;
    if (!S.next(0, cur)) return;
    typedef typename AccOf<Epi::MODE>::T AccT;
    AccT acc[2][2][4][2];
#pragma unroll
    for (int a = 0; a < 2; ++a)
#pragma unroll
        for (int b = 0; b < 2; ++b)
#pragma unroll
            for (int m = 0; m < 4; ++m)
#pragma unroll
                for (int n = 0; n < 2; ++n) acc[a][b][m][n] = AccT{};
    bf16x8 At[4][2], B0[2][2], B1[2][2]; i32x8 At8[4], B08[2], B18[2];
    const char* cA = cur.A; const char* cB = cur.B;
    if constexpr (SP2) {
        PG8_STAGE(PG8_SB(0, 0), cB, voffB); PG8_STAGE(PG8_SB(0, 1), cB + hstepB, voffB); PG8_STAGE(PG8_SA(0, 0), cA, voffA); PG8_STAGE(PG8_SA(0, 1), cA + hstepA, voffA);
        if (wr == 1) PG8_BAR;
        PG8_WAIT_V(2); PG8_BAR;
        PG8_STAGE(PG8_SB(1, 0), cB + kstep, voffB); PG8_STAGE(PG8_SA(1, 0), cA + kstep, voffA); PG8_STAGE(PG8_SB(1, 1), cB + hstepB + kstep, voffB);
        PG8_WAIT_V(6); PG8_BAR;
    } else {
        PG8_STAGE(PG8_SB(0, 0), cB, voffB); PG8_STAGE(PG8_SA(0, 0), cA, voffA); PG8_STAGE(PG8_SB(0, 1), cB + hstepB, voffB); PG8_STAGE(PG8_SA(0, 1), cA + hstepA, voffA);
        if (wr == 1) PG8_BAR;
        PG8_WAIT_V(4); PG8_BAR;
        PG8_STAGE(PG8_SB(1, 0), cB + kstep, voffB); PG8_STAGE(PG8_SA(1, 0), cA + kstep, voffA); PG8_STAGE(PG8_SB(1, 1), cB + hstepB + kstep, voffB);
        PG8_WAIT_V(6); PG8_BAR;
    }
    for (;;) {
        cur.par = ui & 1; if constexpr (Epi::PREFETCH) E.prefetch(cur, wid, lane);
        const bool has_next = S.next(ui + 1, nxt);
        const char* nA = has_next ? nxt.A : cA; const char* nB = has_next ? nxt.B : cB;
        for (int t = 0; t < nt; t += 2) {
            const bool last = (t == nt - 2);
            const char* a1 = cA + (size_t)(t + 1) * kstep;
            const char* a2 = last ? nA : cA + (size_t)(t + 2) * kstep; const char* b2 = last ? nB : cB + (size_t)(t + 2) * kstep;
            const char* a3 = a2 + kstep; const char* b3 = b2 + kstep;
            if constexpr (SP2) {
            PG8_LDB(B0, 0, 0); PG8_LDB(B1, 0, 1); PG8_SCHED; PG8_LDA(At, 0, 0); PG8_STAGE(PG8_SA(1, 1), a1 + hstepA, voffA);
            PG8_WAIT_V(8); PG8_WAIT_L(0); PG8_BAR; PG8_MMA(0, 0, At, B0); PG8_MMA(0, 1, At, B1); PG8_BAR; PG8_SCHED;
            PG8_LDA(At, 0, 1); PG8_STAGE(PG8_SB(0, 0), b2, voffB); PG8_STAGE(PG8_SB(0, 1), b2 + hstepB, voffB); PG8_STAGE(PG8_SA(0, 0), a2, voffA);
            PG8_WAIT_V(8); PG8_WAIT_L(0); PG8_BAR; PG8_MMA(1, 0, At, B0); PG8_MMA(1, 1, At, B1); PG8_BAR; PG8_SCHED;
            PG8_LDB(B0, 1, 0); PG8_LDB(B1, 1, 1); PG8_SCHED; PG8_LDA(At, 1, 0); PG8_STAGE(PG8_SA(0, 1), a2 + hstepA, voffA);
            PG8_WAIT_V(8); PG8_WAIT_L(0); PG8_BAR; PG8_MMA(0, 0, At, B0); PG8_MMA(0, 1, At, B1); PG8_BAR; PG8_SCHED;
            PG8_LDA(At, 1, 1); PG8_STAGE(PG8_SB(1, 0), b3, voffB); PG8_STAGE(PG8_SB(1, 1), b3 + hstepB, voffB); PG8_STAGE(PG8_SA(1, 0), a3, voffA);
            PG8_WAIT_V(8); PG8_WAIT_L(0); PG8_BAR; PG8_MMA(1, 0, At, B0); PG8_MMA(1, 1, At, B1); PG8_BAR; PG8_SCHED;
            } else {
            PG8_LDB(B0, 0, 0); PG8_SCHED; PG8_LDA(At, 0, 0); PG8_STAGE(PG8_SA(1, 1), a1 + hstepA, voffA);
            PG8_WAIT_L(8); PG8_BAR; PG8_WAIT_L(0); PG8_MMA(0, 0, At, B0); PG8_BAR; PG8_SCHED;
            PG8_LDB(B1, 0, 1); PG8_STAGE(PG8_SB(0, 0), b2, voffB);
            PG8_BAR; PG8_WAIT_L(0); PG8_MMA(0, 1, At, B1); PG8_BAR;
            PG8_LDA(At, 0, 1); PG8_STAGE(PG8_SA(0, 0), a2, voffA);
            PG8_BAR; PG8_WAIT_L(0); PG8_MMA(1, 0, At, B0); PG8_BAR; PG8_SCHED;
            PG8_STAGE(PG8_SB(0, 1), b2 + hstepB, voffB);
            PG8_WAIT_V(6); PG8_BAR; PG8_MMA(1, 1, At, B1); PG8_BAR;
            PG8_LDB(B0, 1, 0); PG8_SCHED; PG8_LDA(At, 1, 0); PG8_STAGE(PG8_SA(0, 1), a2 + hstepA, voffA);
            PG8_WAIT_L(8); PG8_BAR; PG8_WAIT_L(0); PG8_MMA(0, 0, At, B0); PG8_BAR; PG8_SCHED;
            PG8_LDB(B1, 1, 1); PG8_STAGE(PG8_SB(1, 0), b3, voffB);
            PG8_BAR; PG8_WAIT_L(0); PG8_MMA(0, 1, At, B1); PG8_BAR;
            PG8_LDA(At, 1, 1); PG8_STAGE(PG8_SA(1, 0), a3, voffA);
            PG8_BAR; PG8_WAIT_L(0); PG8_MMA(1, 0, At, B0); PG8_BAR; PG8_SCHED;
            PG8_STAGE(PG8_SB(1, 1), b3 + hstepB, voffB);
            PG8_WAIT_V(6); PG8_BAR; PG8_MMA(1, 1, At, B1); PG8_BAR;
            }
        }
        if constexpr (ALIGN_EPI) { if (wr == 0) PG8_BAR; }
        if constexpr (Epi::MODE == 2) asm volatile("s_nop 15\n\ts_nop 15" ::: "memory");
        if constexpr (!Epi::AFTER_DRAIN) { E(acc, cur, wr, wc, fr, fq); }
        if (!has_next) break;
#pragma unroll
        for (int a = 0; a < 2; ++a)
#pragma unroll
            for (int b = 0; b < 2; ++b)
#pragma unroll
                for (int m = 0; m < 4; ++m)
#pragma unroll
                    for (int n = 0; n < 2; ++n) acc[a][b][m][n] = AccT{};
        cur = nxt; cA = nA; cB = nB; ++ui;
        if constexpr (ALIGN_EPI) { if (wr == 1) PG8_BAR; }
    }
    PG8_WAIT_V(0);
    if constexpr (!ALIGN_EPI) { if (wr == 0) PG8_BAR; }
    PG8_BAR;
#undef PG8_SA
#undef PG8_SB
#undef PG8_STAGE
#undef PG8_LDA
#undef PG8_LDB
#undef PG8_MMA
#undef PG8_WAIT_V
#undef PG8_WAIT_L
#undef PG8_BAR
#undef PG8_SCHED
}
}
#define XB_TMO      128
#define XB_XCNT(j)  (256  + 64 * (j))
#define XB_XSUB(j)  (1280 + 64 * (j))
#define XB_XGEN(j)  (2304 + 64 * (j))
#define XB_TOP      3328
#define XB_TOPGEN   3392
#define XCD_BAR_WORDS 3456
#define XB_SPIN_CAP (1u << 18)

__device__ __forceinline__ unsigned xb_ld(unsigned* p)              { return __hip_atomic_load(p, __ATOMIC_RELAXED, __HIP_MEMORY_SCOPE_AGENT); }
__device__ __forceinline__ unsigned xb_add(unsigned* p, unsigned v) { return __hip_atomic_fetch_add(p, v, __ATOMIC_RELAXED, __HIP_MEMORY_SCOPE_AGENT); }
__device__ __forceinline__ unsigned xb_xcc_id() { return (unsigned)__builtin_amdgcn_s_getreg((3 << 11) | 20) & 0xFu; }
#define XB_SPIN(cond, bar) do { unsigned _sp = 0; while (cond) { __builtin_amdgcn_s_sleep(1); \
    if ((++_sp & 255u) == 0u) { if (xb_ld(&(bar)[XB_TMO])) break; if (_sp > XB_SPIN_CAP) { atomicAdd(&(bar)[XB_TMO], 1u); break; } } } } while (0)

struct XcdBarrier {
    unsigned* bar; unsigned x;
    volatile LAS unsigned* st;
};

__device__ __forceinline__ XcdBarrier xcd_barrier_post(unsigned* bar, volatile LAS unsigned* st) {
    XcdBarrier b; b.bar = bar; b.x = xb_xcc_id(); b.st = st;
    if (threadIdx.x == 0) (void)xb_add(&bar[XB_XCNT(b.x)], 1u);
    return b;
}
__device__ __forceinline__ void xcd_barrier_complete(unsigned* bar, unsigned x, unsigned& nloc, unsigned& nx) {
    const unsigned G = gridDim.x * gridDim.y * gridDim.z;
    unsigned sum, cnt, mine, sp = 0u;
    for (;;) {
        sum = 0u; cnt = 0u; mine = 0u;
#pragma unroll
        for (unsigned j = 0; j < 16; ++j) { const unsigned c = xb_ld(&bar[XB_XCNT(j)]); sum += c; cnt += (c > 0u) ? 1u : 0u; mine = (j == x) ? c : mine; }
        if (sum == G) break;
        __builtin_amdgcn_s_sleep(1);
        if ((++sp & 255u) == 0u) { if (xb_ld(&bar[XB_TMO])) break; if (sp > XB_SPIN_CAP) { atomicAdd(&bar[XB_TMO], 1u); break; } }
    }
    nloc = mine > 0u ? mine : 1u; nx = cnt > 0u ? cnt : 1u;
}

__device__ __forceinline__ void xcd_barrier(const XcdBarrier& b) {
    asm volatile("s_waitcnt vmcnt(0)" ::: "memory");
    __syncthreads();
    if (threadIdx.x == 0) {
        unsigned* bar = b.bar;
        __builtin_amdgcn_s_waitcnt(0);
        unsigned nloc = b.st[0], nx = b.st[1];
        if (nloc == 0u) { xcd_barrier_complete(bar, b.x, nloc, nx); b.st[0] = nloc; b.st[1] = nx; }
        const unsigned old = xb_add(&bar[XB_XSUB(b.x)], 1u);
        const unsigned gen = old / nloc;
        if (old + 1u == (gen + 1u) * nloc) {
            __builtin_amdgcn_fence(__ATOMIC_RELEASE, "agent");
            asm volatile("s_waitcnt vmcnt(0)" ::: "memory");
            const unsigned og = xb_add(&bar[XB_TOP], 1u);
            const unsigned tg = og / nx;
            if (og + 1u == (tg + 1u) * nx) xb_add(&bar[XB_TOPGEN], 1u);
            else XB_SPIN(xb_ld(&bar[XB_TOPGEN]) == tg, bar);
            __builtin_amdgcn_fence(__ATOMIC_ACQUIRE, "agent");
            xb_add(&bar[XB_XGEN(b.x)], 1u);
            asm volatile("s_waitcnt vmcnt(0)" ::: "memory");
        } else {
            XB_SPIN(xb_ld(&bar[XB_XGEN(b.x)]) == gen, bar);
            __builtin_amdgcn_fence(__ATOMIC_ACQUIRE, "agent");
            asm volatile("s_waitcnt vmcnt(0)" ::: "memory");
        }
    }
    __syncthreads();
}
namespace att {
constexpr int KSLOT = 6144, VSLOT = 4096;
constexpr int L_K = 0, L_V = 3 * KSLOT, L_WS = L_V + 3 * VSLOT, L_OST = L_WS + 8 * 256, L_CONST = L_OST + 8 * 8192, L_END = L_CONST + 1536;
static_assert(L_END <= RING_BYTES, "attention LDS");
__device__ __forceinline__ int crow(int r, int hi) { return (r & 3) + 8 * (r >> 2) + 4 * hi; }
__device__ __forceinline__ unsigned pkbf(float lo, float hi) { f32x2 v = {lo, hi}; typedef __bf16 bf2 __attribute__((ext_vector_type(2))); bf2 b = __builtin_convertvector(v, bf2); return __builtin_bit_cast(unsigned, b); }
template <bool SAFE>
__device__ __forceinline__ bool attn_unit_impl(const unsigned char* Qw, const unsigned char* __restrict__ Kh, const unsigned char* __restrict__ Vt, bf16_t* Ow, int NT, int nwact, LAS unsigned char* shm) {
    const int tid = otid(), lane = tid & 63, r32 = lane & 31, hi = lane >> 5; const int wid = __builtin_amdgcn_readfirstlane(tid >> 6);
    const bool act = wid < nwact; asm volatile("" : "+s"(NT));
    const int kc6 = wid < 6 ? wid : wid - 6, vw = wid & 3;
    LAS unsigned char* kd0 = shm + L_K + kc6 * 1024; LAS unsigned char* vd = shm + L_V + vw * 1024;
#define DMA_TILE(t, kslot, vslot) do { int l_ = lane; asm volatile("" : "+v"(l_)); \
        __builtin_amdgcn_global_load_lds((const unsigned*)(Kh + (size_t)(t) * 64 * 768 + ((unsigned)l_ * 768u + (unsigned)kc6 * 16u)), (LAS unsigned*)(kd0 + (kslot) * KSLOT), 16, 0, 0); \
        __builtin_amdgcn_global_load_lds((const unsigned*)(Vt + (size_t)(t) * 4096 + ((unsigned)(vw * 16 + (l_ >> 2)) * 64u + (unsigned)(((l_ & 3) ^ ((l_ >> 4) & 3)) * 16))), (LAS unsigned*)(vd + (vslot) * VSLOT), 16, 0, 0); } while (0)
    pg8::i32x8 qa1, qa2, qb1, qb2;
    { const int wq = act ? wid : 0;
      const unsigned char* ra = Qw + (size_t)(wq * 64 + r32) * 768; const unsigned char* rb = ra + (size_t)32 * 768;
      const pg8::i32x4 z4 = {0, 0, 0, 0}, two4 = {0x40, 0, 0, 0};
      const pg8::i32x4 a0_ = *(const pg8::i32x4*)(ra + 32 * hi), a1_ = *(const pg8::i32x4*)(ra + 32 * hi + 16), a2_ = hi ? two4 : *(const pg8::i32x4*)(ra + 64), a3_ = hi ? z4 : *(const pg8::i32x4*)(ra + 80);
      const pg8::i32x4 b0_ = *(const pg8::i32x4*)(rb + 32 * hi), b1_ = *(const pg8::i32x4*)(rb + 32 * hi + 16), b2_ = hi ? two4 : *(const pg8::i32x4*)(rb + 64), b3_ = hi ? z4 : *(const pg8::i32x4*)(rb + 80);
      qa1 = __builtin_shufflevector(a0_, a1_, 0, 1, 2, 3, 4, 5, 6, 7); qa2 = __builtin_shufflevector(a2_, a3_, 0, 1, 2, 3, 4, 5, 6, 7);
      qb1 = __builtin_shufflevector(b0_, b1_, 0, 1, 2, 3, 4, 5, 6, 7); qb2 = __builtin_shufflevector(b2_, b3_, 0, 1, 2, 3, 4, 5, 6, 7); }
    if (tid < 384) ((LAS unsigned*)(shm + L_CONST))[tid] = (tid == 0 || tid == 64) ? 0xC0u : 0u;
    DMA_TILE(0, 0, 0);
    f32x16 oa[2], ob[2]; oa[0] = f32x16{}; oa[1] = f32x16{}; ob[0] = f32x16{}; ob[1] = f32x16{}; float la = 0.f, lb = 0.f, ovf = 0.f;
    const int keyr = 32 * ((r32 >> 2) & 1) + (r32 & 3) + 4 * (r32 >> 3);
    const LAS unsigned char* kp0 = shm + L_K + hi * 2048 + keyr * 16;
    const LAS unsigned char* kp1 = shm + L_K + 4096 + keyr * 16;
    const LAS unsigned char* kcc = shm + L_CONST;
    const int vsw = (r32 >> 2) & 3;
    const LAS unsigned char* vp0 = shm + L_V + r32 * 64 + ((2 * hi) ^ vsw) * 16;
    f32x16 a0, a1, b0, b1; pg8::i32x8 pa = {0, 0, 0, 0, 0, 0, 0, 0}, pb = {0, 0, 0, 0, 0, 0, 0, 0};
    pg8::i32x8 K0, K1, K0x, K1x, V0, V1;
#define MF8(A_, B_, C_) __builtin_amdgcn_mfma_scale_f32_32x32x64_f8f6f4(A_, B_, C_, 0, 0, 0, 0x7F7F7F7F, 0, 0x7F7F7F7F)
#define CAT8(x_, y_) __builtin_shufflevector(x_, y_, 0, 1, 2, 3, 4, 5, 6, 7)
#define LDK(ks_) do { const LAS unsigned char* kb = kp0 + (ks_) * KSLOT; const LAS unsigned char* kc = hi ? kcc : kp1 + (ks_) * KSLOT; \
        const pg8::i32x4 k0a = *(const LAS pg8::i32x4*)(kb), k0b = *(const LAS pg8::i32x4*)(kb + 1024), k1a = *(const LAS pg8::i32x4*)(kb + 256), k1b = *(const LAS pg8::i32x4*)(kb + 1280); \
        const pg8::i32x4 k0c = *(const LAS pg8::i32x4*)(kc), k0d = *(const LAS pg8::i32x4*)(kc + 1024), k1c = *(const LAS pg8::i32x4*)(kc + 256), k1d = *(const LAS pg8::i32x4*)(kc + 1280); \
        K0 = CAT8(k0a, k0b); K1 = CAT8(k1a, k1b); K0x = CAT8(k0c, k0d); K1x = CAT8(k1c, k1d); } while (0)
#define LDV(vs_) do { const LAS unsigned char* va = vp0 + (vs_) * VSLOT; const LAS unsigned char* vb = (const LAS unsigned char*)(uintptr_t)((unsigned)(uintptr_t)va ^ 16u);   \
        const pg8::i32x4 v0a = *(const LAS pg8::i32x4*)(va), v0b = *(const LAS pg8::i32x4*)(vb), v1a = *(const LAS pg8::i32x4*)(va + 2048), v1b = *(const LAS pg8::i32x4*)(vb + 2048); \
        V0 = CAT8(v0a, v0b); V1 = CAT8(v1a, v1b); } while (0)
#define PK4(o_, x_, i_) ({ int w_ = __builtin_amdgcn_cvt_pk_fp8_f32(SAFE ? fminf(x_[i_], 448.f) : x_[i_], SAFE ? fminf(x_[i_ + 1], 448.f) : x_[i_ + 1], o_, false); __builtin_amdgcn_cvt_pk_fp8_f32(SAFE ? fminf(x_[i_ + 2], 448.f) : x_[i_ + 2], SAFE ? fminf(x_[i_ + 3], 448.f) : x_[i_ + 3], w_, true); })
#define SOFT32(x0_, x1_, l_, p_) do { float s_ = 0.f; \
        _Pragma("unroll") for (int r = 0; r < 16; ++r) { x0_[r] = __builtin_amdgcn_exp2f(x0_[r]); x1_[r] = __builtin_amdgcn_exp2f(x1_[r]); s_ += x0_[r] + x1_[r]; } \
        l_ += s_; ovf = fmaxf(ovf, s_); \
        p_ = (pg8::i32x8){PK4(p_[0], x0_, 0), PK4(p_[1], x0_, 4), PK4(p_[2], x0_, 8), PK4(p_[3], x0_, 12), PK4(p_[4], x1_, 0), PK4(p_[5], x1_, 4), PK4(p_[6], x1_, 8), PK4(p_[7], x1_, 12)}; } while (0)
#define TOPSYNC() do { asm volatile("s_waitcnt vmcnt(0)" ::: "memory"); __builtin_amdgcn_s_barrier(); asm volatile("" ::: "memory"); } while (0)
    const f32x16 z16 = {};
    DMA_TILE(1, 1, 1);
    int ks = 0, vs = 0, s2 = 2;
    for (int t = 0; t < NT; ++t) {
        asm volatile("s_waitcnt vmcnt(2)" ::: "memory"); __builtin_amdgcn_s_barrier(); asm volatile("" ::: "memory");
        { const int tn = (t + 2 < NT) ? t + 2 : NT - 1; DMA_TILE(tn, s2, s2); }
        LDK(ks);
        a0 = MF8(K0, qa1, z16); a1 = MF8(K1, qa1, z16); a0 = MF8(K0x, qa2, a0); a1 = MF8(K1x, qa2, a1);
        __builtin_amdgcn_sched_barrier(0);
        b0 = MF8(K0, qb1, z16); b1 = MF8(K1, qb1, z16); b0 = MF8(K0x, qb2, b0); b1 = MF8(K1x, qb2, b1);
        SOFT32(a0, a1, la, pa);
        __builtin_amdgcn_sched_barrier(0); LDV(vs);
        __builtin_amdgcn_sched_barrier(0);
        oa[0] = MF8(pa, V0, oa[0]); oa[1] = MF8(pa, V1, oa[1]);
        SOFT32(b0, b1, lb, pb);
        __builtin_amdgcn_sched_barrier(0);
        ob[0] = MF8(pb, V0, ob[0]); ob[1] = MF8(pb, V1, ob[1]);
        __builtin_amdgcn_sched_barrier(0);
        ks = (ks == 2) ? 0 : ks + 1; vs = ks; s2 = (s2 == 2) ? 0 : s2 + 1;
    }
    asm volatile("s_waitcnt vmcnt(0)" ::: "memory");
#undef MF8
#undef CAT8
#undef LDK
#undef LDV
#undef PK4
#undef SOFT32
#undef TOPSYNC
#undef DMA_TILE
    { auto rr = __builtin_amdgcn_permlane32_swap(__float_as_uint(la), __float_as_uint(la), false, false); la = __uint_as_float(rr[0]) + __uint_as_float(rr[1]); }
    { auto rr = __builtin_amdgcn_permlane32_swap(__float_as_uint(lb), __float_as_uint(lb), false, false); lb = __uint_as_float(rr[0]) + __uint_as_float(rr[1]); }
    LAS float* wsf = (LAS float*)(shm + L_WS) + wid * 64;
    if (hi == 0) { wsf[r32] = la; wsf[32 + r32] = lb; }
    if (!SAFE) { if (__builtin_amdgcn_ballot_w64(ovf >= 448.f) != 0 && lane == 0) ((volatile LAS unsigned*)(shm + L_CONST))[380] = 1u; }
    asm volatile("s_waitcnt lgkmcnt(0)" ::: "memory");
    if (act) {
        LAS bf16_t* stg = (LAS bf16_t*)(shm + L_OST) + wid * 4096;
#pragma unroll
        for (int r = 0; r < 16; ++r) { const int orow = crow(r, hi); const float ra = __builtin_amdgcn_rcpf(wsf[orow]), rb = __builtin_amdgcn_rcpf(wsf[32 + orow]);
#pragma unroll
            for (int d0 = 0; d0 < 2; ++d0) { stg[orow * 64 + d0 * 32 + r32] = (bf16_t)(pkbf(oa[d0][r] * ra, 0.f) & 0xffffu); stg[(32 + orow) * 64 + d0 * 32 + r32] = (bf16_t)(pkbf(ob[d0][r] * rb, 0.f) & 0xffffu); } }
        asm volatile("s_waitcnt lgkmcnt(0)" ::: "memory");
#pragma unroll
        for (int i = 0; i < 8; ++i) { const int row = i * 8 + (lane >> 3), ch = lane & 7; const u32x4 v = *(const LAS u32x4*)(stg + row * 64 + ch * 8); *(u32x4*)(Ow + (size_t)(wid * 64 + row) * 512 + ch * 8) = v; }
    }
    asm volatile("s_waitcnt lgkmcnt(0)" ::: "memory"); __builtin_amdgcn_s_barrier(); asm volatile("" ::: "memory");
    bool redo = false;
    if (!SAFE) { redo = __builtin_amdgcn_readfirstlane((int)((volatile LAS unsigned*)(shm + L_CONST))[380]) != 0;
        asm volatile("s_waitcnt lgkmcnt(0)" ::: "memory"); __builtin_amdgcn_s_barrier(); asm volatile("" ::: "memory"); }
    return redo;
}
__device__ __forceinline__ void attn_unit(const unsigned char* Qw, const unsigned char* __restrict__ Kh, const unsigned char* __restrict__ Vt, bf16_t* Ow, int NT, int nwact, LAS unsigned char* shm) {
    if (attn_unit_impl<false>(Qw, Kh, Vt, Ow, NT, nwact, shm)) (void)attn_unit_impl<true>(Qw, Kh, Vt, Ow, NT, nwact, shm);
}
}
namespace fft {
constexpr size_t MIDC = (size_t)4 * 4 * 128 * 64 * 128;
__device__ __forceinline__ bf16x8 mk8(unsigned a, unsigned b, unsigned c, unsigned d) { u32x4 v = {a, b, c, d}; return __builtin_bit_cast(bf16x8, v); }
__device__ __forceinline__ unsigned pkbf(float lo, float hi) { return att::pkbf(lo, hi); }

__device__ __forceinline__ void fft1_phase(const bf16_t* P, bf16_t* MID, LAS unsigned char* lds, int vcu, int G) {
    const int tid = otid(), lane = tid & 63, c_ = lane & 15, q = lane >> 4; const int wid = __builtin_amdgcn_readfirstlane(tid >> 6);
    LAS unsigned char* Dl = lds; LAS unsigned char* ST = lds + 18432;
    int salt; asm volatile("v_mov_b32 %0, 0" : "=v"(salt));
    bf16x8 ccf[4], scf[4];
#pragma unroll
    for (int s = 0; s < 4; ++s) { unsigned cw[4], sw[4];
#pragma unroll
        for (int j = 0; j < 8; j += 2) { float s0, c0, s1, c1; const int m = 16 * wid + c_, ca = 32 * s + 8 * q + j + salt;
            sincospif((float)((ca * m) & 127) * (1.f / 64.f), &s0, &c0); sincospif((float)(((ca + 1) * m) & 127) * (1.f / 64.f), &s1, &c1);
            cw[j >> 1] = pkbf(c0, c1); sw[j >> 1] = pkbf(s0, s1); }
        ccf[s] = mk8(cw[0], cw[1], cw[2], cw[3]); scf[s] = mk8(sw[0], sw[1], sw[2], sw[3]); }
    bf16x8 c64f[4][2], s64f[4][2];
#pragma unroll
    for (int kt = 0; kt < 4; ++kt)
#pragma unroll
        for (int s = 0; s < 2; ++s) { unsigned cw[4], sw[4];
#pragma unroll
            for (int j = 0; j < 8; j += 2) { float s0, c0, s1, c1; const int k1 = 16 * kt + c_ + salt, t1 = 32 * s + (j < 4 ? 4 * q + j : 16 + 4 * q + j - 4);
                sincospif((float)((k1 * t1) & 63) * (1.f / 32.f), &s0, &c0); sincospif((float)((k1 * (t1 + 1)) & 63) * (1.f / 32.f), &s1, &c1);
                cw[j >> 1] = pkbf(c0, c1); sw[j >> 1] = pkbf(s0, s1); }
            c64f[kt][s] = mk8(cw[0], cw[1], cw[2], cw[3]); s64f[kt][s] = mk8(sw[0], sw[1], sw[2], sw[3]); }
    u32x4 nd0, nd1;
    { const int it0 = vcu < 2048 ? vcu : 0; const int b = it0 >> 9, g = (it0 >> 7) & 3, t2 = it0 & 127; const int row = tid >> 3, ch = tid & 7;
      const bf16_t* src = P + ((size_t)b * SB + 128 * row + t2) * INW + 544 + 128 * g + ch * 16; nd0 = *(const u32x4*)src; nd1 = *(const u32x4*)(src + 8); }
    for (int item = vcu; item < 2048; item += G) {
        const int b = item >> 9, g = (item >> 7) & 3, t2 = item & 127;
        { const int row = tid >> 3, ch = tid & 7;
          *(LAS u32x4*)(Dl + row * 288 + ch * 32) = nd0; *(LAS u32x4*)(Dl + row * 288 + ch * 32 + 16) = nd1;
          const int nit = (item + G < 2048) ? item + G : item; const int nb = nit >> 9, ng = (nit >> 7) & 3, nt2 = nit & 127;
          const bf16_t* src = P + ((size_t)nb * SB + 128 * row + nt2) * INW + 544 + 128 * ng + ch * 16; nd0 = *(const u32x4*)src; nd1 = *(const u32x4*)(src + 8); }
        __syncthreads();
        f32x4 aA[4], aB[4];
#pragma unroll
        for (int i = 0; i < 4; ++i) { aA[i] = (f32x4){0.f, 0.f, 0.f, 0.f}; aB[i] = (f32x4){0.f, 0.f, 0.f, 0.f}; }
#pragma unroll
        for (int s = 0; s < 4; ++s)
#pragma unroll
            for (int i = 0; i < 4; ++i) { const bf16x8 af = *(const LAS bf16x8*)(Dl + (16 * i + c_) * 288 + (32 * s + 8 * q) * 2);
                aA[i] = __builtin_amdgcn_mfma_f32_16x16x32_bf16(af, ccf[s], aA[i], 0, 0, 0); aB[i] = __builtin_amdgcn_mfma_f32_16x16x32_bf16(af, scf[s], aB[i], 0, 0, 0); }
        unsigned xa[4][2], xb[4][2];
#pragma unroll
        for (int i = 0; i < 4; ++i) { xa[i][0] = pkbf(aA[i][0], aA[i][1]); xa[i][1] = pkbf(aA[i][2], aA[i][3]); xb[i][0] = pkbf(aB[i][0], aB[i][1]); xb[i][1] = pkbf(aB[i][2], aB[i][3]); }
        bf16x8 fA[2], fB[2], fNB[2];
#pragma unroll
        for (int s = 0; s < 2; ++s) { fA[s] = mk8(xa[2 * s][0], xa[2 * s][1], xa[2 * s + 1][0], xa[2 * s + 1][1]); fB[s] = mk8(xb[2 * s][0], xb[2 * s][1], xb[2 * s + 1][0], xb[2 * s + 1][1]);
            fNB[s] = mk8(xb[2 * s][0] ^ 0x80008000u, xb[2 * s][1] ^ 0x80008000u, xb[2 * s + 1][0] ^ 0x80008000u, xb[2 * s + 1][1] ^ 0x80008000u); }
#pragma unroll
        for (int kt = 0; kt < 4; ++kt) { f32x4 yr = (f32x4){0.f, 0.f, 0.f, 0.f}, wi = (f32x4){0.f, 0.f, 0.f, 0.f};
#pragma unroll
            for (int s = 0; s < 2; ++s) {
                yr = __builtin_amdgcn_mfma_f32_16x16x32_bf16(fA[s], c64f[kt][s], yr, 0, 0, 0); yr = __builtin_amdgcn_mfma_f32_16x16x32_bf16(fNB[s], s64f[kt][s], yr, 0, 0, 0);
                wi = __builtin_amdgcn_mfma_f32_16x16x32_bf16(fB[s], c64f[kt][s], wi, 0, 0, 0); wi = __builtin_amdgcn_mfma_f32_16x16x32_bf16(fA[s], s64f[kt][s], wi, 0, 0, 0); }
            const int k1 = 16 * kt + c_; float ts, tr; sincospif((float)(k1 * t2) * (1.f / 4096.f), &ts, &tr);
            const f32x4 ypr = yr * tr - wi * ts, wpi = yr * ts + wi * tr;
            LAS unsigned char* sp = ST + k1 * 272 + (16 * wid + 4 * q) * 2;
            *(LAS u32x2*)sp = (u32x2){pkbf(ypr[0], ypr[1]), pkbf(ypr[2], ypr[3])}; *(LAS u32x2*)(sp + 17408) = (u32x2){pkbf(wpi[0], wpi[1]), pkbf(wpi[2], wpi[3])}; }
        __syncthreads();
#pragma unroll
        for (int p = 0; p < 4; ++p) { const int idx = p * 512 + tid, comp = idx >> 10, rem = idx & 1023, k1 = rem >> 4, ch = rem & 15;
            const u32x4 v = *(const LAS u32x4*)(ST + comp * 17408 + k1 * 272 + ch * 16);
            *(u32x4*)(MID + comp * MIDC + ((((size_t)b * 4 + g) * 128 + t2) * 64 + k1) * 128 + ch * 8) = v; }
    }
    __syncthreads();
}

__device__ __forceinline__ void fft2_phase(const bf16_t* MID, bf16_t* FOUR, LAS unsigned char* lds, int vcu, int G) {
    const int tid = otid(), lane = tid & 63, r32 = lane & 31, hi = lane >> 5; const int wid = __builtin_amdgcn_readfirstlane(tid >> 6), kt = wid & 3, mh = wid >> 2;
    LAS unsigned char* DT = lds; LAS unsigned char* ST = lds + 65536;
    int salt; asm volatile("v_mov_b32 %0, 0" : "=v"(salt));
    bf16x8 cf[8], nsf[8];
#pragma unroll
    for (int s = 0; s < 8; ++s) { unsigned cw[4], sw[4];
#pragma unroll
        for (int j = 0; j < 8; j += 2) { float s0, c0, s1, c1; const int k2 = 32 * kt + r32 + salt, t2 = 16 * s + (j < 4 ? 4 * hi + j : 8 + 4 * hi + j - 4);
            sincospif((float)((k2 * t2) & 127) * (1.f / 64.f), &s0, &c0); sincospif((float)((k2 * (t2 + 1)) & 127) * (1.f / 64.f), &s1, &c1);
            cw[j >> 1] = pkbf(c0, c1); sw[j >> 1] = pkbf(-s0, -s1); }
        cf[s] = mk8(cw[0], cw[1], cw[2], cw[3]); nsf[s] = mk8(sw[0], sw[1], sw[2], sw[3]); }
    const int vb = (int)(unsigned)(uintptr_t)DT + mh * 16384 + ((lane >> 4) & 1) * 32 + (lane & 3) * 8 + (4 * hi + ((lane & 15) >> 2)) * 64;
    for (int item = vcu; item < 1024; item += G) {
        const int b = item >> 8, g = (item >> 6) & 3, k1 = item & 63;
        u32x4 dv[2][4];
#pragma unroll
        for (int comp = 0; comp < 2; ++comp)
#pragma unroll
            for (int i = 0; i < 4; ++i) { const int idx = i * 512 + tid, t2 = idx >> 4, ch = idx & 15;
                dv[comp][i] = *(const u32x4*)(MID + comp * MIDC + ((((size_t)b * 4 + g) * 128 + t2) * 64 + k1) * 128 + ch * 8); }
#pragma unroll
        for (int comp = 0; comp < 2; ++comp)
#pragma unroll
            for (int i = 0; i < 4; ++i) { const int idx = i * 512 + tid, t2 = idx >> 4, ch = idx & 15;
                *(LAS u32x4*)(DT + comp * 32768 + (ch >> 2) * 8192 + (t2 >> 4) * 1024 + (t2 & 15) * 64 + (ch & 3) * 16) = dv[comp][i]; }
        __syncthreads();
        f32x16 acc[2]; acc[0] = f32x16{}; acc[1] = f32x16{};
#pragma unroll
        for (int mql = 0; mql < 2; ++mql)
#pragma unroll
            for (int s = 0; s < 8; ++s) { s16x4 l0, h0, l1, h1;
                asm volatile("ds_read_b64_tr_b16 %0,%1 offset:%c2" : "=&v"(l0) : "v"(vb), "i"(mql * 8192 + s * 1024) : "memory");
                asm volatile("ds_read_b64_tr_b16 %0,%1 offset:%c2" : "=&v"(h0) : "v"(vb), "i"(mql * 8192 + s * 1024 + 512) : "memory");
                asm volatile("ds_read_b64_tr_b16 %0,%1 offset:%c2" : "=&v"(l1) : "v"(vb), "i"(32768 + mql * 8192 + s * 1024) : "memory");
                asm volatile("ds_read_b64_tr_b16 %0,%1 offset:%c2" : "=&v"(h1) : "v"(vb), "i"(32768 + mql * 8192 + s * 1024 + 512) : "memory");
                asm volatile("s_waitcnt lgkmcnt(0)" ::: "memory"); __builtin_amdgcn_sched_barrier(0);
                const bf16x8 a0 = (bf16x8){l0[0], l0[1], l0[2], l0[3], h0[0], h0[1], h0[2], h0[3]}, a1 = (bf16x8){l1[0], l1[1], l1[2], l1[3], h1[0], h1[1], h1[2], h1[3]};
                acc[mql] = __builtin_amdgcn_mfma_f32_32x32x16_bf16(a0, cf[s], acc[mql], 0, 0, 0); acc[mql] = __builtin_amdgcn_mfma_f32_32x32x16_bf16(a1, nsf[s], acc[mql], 0, 0, 0); }
        const int k2 = 32 * kt + r32;
#pragma unroll
        for (int mql = 0; mql < 2; ++mql)
#pragma unroll
            for (int a = 0; a < 4; ++a) { const int m = 32 * (2 * mh + mql) + 8 * a + 4 * hi; const float sc = 1.f / 1024.f;
                *(LAS u32x2*)(ST + k2 * 272 + m * 2) = (u32x2){pkbf(acc[mql][4 * a] * sc, acc[mql][4 * a + 1] * sc), pkbf(acc[mql][4 * a + 2] * sc, acc[mql][4 * a + 3] * sc)}; }
        __syncthreads();
#pragma unroll
        for (int p = 0; p < 4; ++p) { const int idx = p * 512 + tid, kk = idx >> 4, ch = idx & 15;
            const u32x4 v = *(const LAS u32x4*)(ST + kk * 272 + ch * 16);
            *(u32x4*)(FOUR + ((size_t)b * SB + k1 + 64 * kk) * 512 + g * 128 + ch * 8) = v; }
    }
    __syncthreads();
}

__device__ __forceinline__ void ctxfour_phase(const bf16_t* P, bf16_t* FOUR, LAS unsigned char* lds, int vcu, int G) {
    const int tid = otid(), lane = tid & 63, fr = lane & 15, fq = lane >> 4; const int wid = __builtin_amdgcn_readfirstlane(tid >> 6);
    LAS unsigned short* Dl = (LAS unsigned short*)lds;
    LAS float* ct = (LAS float*)(lds + 69632); LAS float* st = ct + 256;
    LAS unsigned short* Zl = (LAS unsigned short*)(lds + 71680);
    LAS unsigned short* Ol = (LAS unsigned short*)(lds + 71680 + 8448);
    if (tid < 256) { float s, c; sincospif((float)tid * (1.f / 128.f), &s, &c); ct[tid] = c; st[tid] = s; }
    for (int item = vcu; item < 256; item += G) {
        const int b = item >> 6, g = (item >> 4) & 3, mc = item & 15, m0 = 8 * mc;
        __syncthreads();
#pragma unroll
        for (int i = 0; i < 8; ++i) { const int idx = i * 512 + tid, t = idx >> 4, ch = idx & 15;
            const u32x4 v = *(const u32x4*)(P + ((size_t)b * SB + SEQ + t) * INW + 544 + 128 * g + ch * 8);
            *(LAS u32x4*)((LAS unsigned char*)Dl + t * 272 + ch * 16) = v; }
        __syncthreads();
        bf16x8 tw[4];
        { const int m = m0 + (fr & 7); const LAS float* tb = (fr < 8) ? ct : st;
#pragma unroll
          for (int ks = 0; ks < 4; ++ks) { float v[8];
#pragma unroll
              for (int i = 0; i < 8; ++i) v[i] = tb[(2 * m * (32 * ks + 8 * fq + i)) & 255];
              tw[ks] = mk8(pkbf(v[0], v[1]), pkbf(v[2], v[3]), pkbf(v[4], v[5]), pkbf(v[6], v[7])); } }
#pragma unroll
        for (int tt = 0; tt < 2; ++tt) { const int tile = 2 * wid + tt; f32x4 acc = {0.f, 0.f, 0.f, 0.f};
#pragma unroll
            for (int ks = 0; ks < 4; ++ks) { const bf16x8 a = *(const LAS bf16x8*)((const LAS unsigned char*)Dl + (16 * tile + fr) * 272 + (32 * ks + 8 * fq) * 2);
                acc = __builtin_amdgcn_mfma_f32_16x16x32_bf16(a, tw[ks], acc, 0, 0, 0); }
            *(LAS u32x2*)(Zl + fr * 264 + 16 * tile + 4 * fq) = (u32x2){pkbf(acc[0], acc[1]), pkbf(acc[2], acc[3])}; }
        __syncthreads();
#pragma unroll 1
        for (int kt = 0; kt < 2; ++kt) { const int tile = 2 * wid + kt, k = 16 * tile + fr; f32x4 acc = {0.f, 0.f, 0.f, 0.f};
#pragma unroll 4
            for (int ks = 0; ks < 16; ++ks) { const int part = ks >> 3, t0 = 32 * (ks & 7) + 8 * fq; float v[8];
#pragma unroll
                for (int i = 0; i < 8; ++i) { const int idx = (k * (t0 + i)) & 255; v[i] = part ? -st[idx] : ct[idx]; }
                const bf16x8 a = mk8(pkbf(v[0], v[1]), pkbf(v[2], v[3]), pkbf(v[4], v[5]), pkbf(v[6], v[7]));
                const bf16x8 bz = *(const LAS bf16x8*)(Zl + (part * 8 + (fr & 7)) * 264 + t0);
                acc = __builtin_amdgcn_mfma_f32_16x16x32_bf16(a, bz, acc, 0, 0, 0); }
            const float sc = 0.005524271728019903f;
            if (fr < 8) {
#pragma unroll
                for (int r = 0; r < 4; ++r) Ol[(16 * tile + 4 * fq + r) * 8 + fr] = (unsigned short)(pkbf(acc[r] * sc, 0.f) & 0xffffu); } }
        __syncthreads();
        if (tid < 256) *(u32x4*)(FOUR + ((size_t)b * SB + SEQ + tid) * 512 + g * 128 + m0) = *(const LAS u32x4*)(Ol + tid * 8);
    }
    __syncthreads();
}
}
__device__ __forceinline__ unsigned pk2(float lo, float hi) { return att::pkbf(lo, hi); }
__device__ __forceinline__ float c448(float x) { return __builtin_amdgcn_fmed3f(x, -448.f, 448.f); }
__device__ __forceinline__ unsigned pk4f8(float a, float b, float c, float d) { int w = 0; w = __builtin_amdgcn_cvt_pk_fp8_f32(c448(a), c448(b), w, false); w = __builtin_amdgcn_cvt_pk_fp8_f32(c448(c), c448(d), w, true); return (unsigned)w; }

__device__ __forceinline__ void tr_item(const float* W, int ldw, int k0, int n0, bf16_t* WT, int ldk, int orow0, const float* ks, LAS float* scr, int lane) {
#pragma unroll 8
    for (int i = 0; i < 32; ++i) { const int kk = 2 * i + (lane >> 5); float v = W[(size_t)(k0 + kk) * ldw + n0 + (lane & 31)]; if (ks) v *= ks[k0 + kk]; scr[kk * 33 + (lane & 31)] = v; }
    LDS_WAIT(); asm volatile("" ::: "memory");
    const int c = lane & 7;
#pragma unroll
    for (int j = 0; j < 4; ++j) { const int n = (lane >> 3) + 8 * j; const LAS float* s = scr + (8 * c) * 33 + n;
        u32x4 o; o.x = pk2(s[0 * 33], s[1 * 33]); o.y = pk2(s[2 * 33], s[3 * 33]); o.z = pk2(s[4 * 33], s[5 * 33]); o.w = pk2(s[6 * 33], s[7 * 33]);
        *(u32x4*)(WT + (size_t)(orow0 + n) * ldk + k0 + 8 * c) = o; }
    LDS_WAIT(); asm volatile("" ::: "memory");
}
__device__ __forceinline__ void conv_mat(const float* W, int K, int N, bf16_t* WT, int mode, const float* ks, int& off, int gw, int NGW, LAS float* scr, int lane) {
    const int nnb = N / 32, items = (K / 64) * nnb;
    const int start = (gw + NGW - (off % NGW)) % NGW;
    for (int it = start; it < items; it += NGW) { const int kb = it / nnb, nb = it - kb * nnb, n0 = nb * 32;
        const int orow0 = (mode == 0) ? n0 : 256 * (n0 >> 7) + 128 * (mode - 1) + (n0 & 127);
        tr_item(W, N, kb * 64, n0, WT, K, orow0, ks, scr, lane); }
    off += items;
}

__device__ __forceinline__ void conv_mat_f8(const float* W, int K, int N, unsigned char* WT, float sc, int& off, int gw, int NGW, LAS float* scr, int lane) {
    const int nnb = N / 32, items = (K / 64) * nnb;
    const int start = (gw + NGW - (off % NGW)) % NGW;
    for (int it = start; it < items; it += NGW) { const int kb = it / nnb, nb = it - kb * nnb, n0 = nb * 32;
        const float* p = W + (size_t)(kb * 64 + (lane >> 5)) * N + n0 + (lane & 31); const size_t st = (size_t)2 * N; LAS float* sq = scr + (lane >> 5) * 33 + (lane & 31);
#pragma unroll 8
        for (int i = 0; i < 32; ++i) { sq[(2 * i) * 33] = *p * sc; p += st; }
        LDS_WAIT(); asm volatile("" ::: "memory");
        const int n = lane >> 1, hf = lane & 1; const LAS float* sp = scr + (32 * hf) * 33 + n; int pk[8];
#pragma unroll
        for (int j = 0; j < 8; ++j) { int w = 0; w = __builtin_amdgcn_cvt_pk_fp8_f32(sp[(4 * j) * 33], sp[(4 * j + 1) * 33], w, false); w = __builtin_amdgcn_cvt_pk_fp8_f32(sp[(4 * j + 2) * 33], sp[(4 * j + 3) * 33], w, true); pk[j] = w; }
        u32x4* dst = (u32x4*)(WT + (size_t)(n0 + n) * K + kb * 64 + 32 * hf);
        dst[0] = (u32x4){(unsigned)pk[0], (unsigned)pk[1], (unsigned)pk[2], (unsigned)pk[3]}; dst[1] = (u32x4){(unsigned)pk[4], (unsigned)pk[5], (unsigned)pk[6], (unsigned)pk[7]};
        LDS_WAIT(); asm volatile("" ::: "memory"); }
    off += items;
}
constexpr int QW_BUF = 69632, QW_STRIDE = 1040, QW_CM = QW_BUF + 32 * QW_STRIDE;
static_assert(QW_CM + 1024 <= RING_BYTES, "quantiser LDS");
__device__ __forceinline__ void quant_wg(const float* W, int N, signed char* WT, float* cm, int mode, int& off, int vcu, int G, LAS unsigned char* lds, int tid) {
    const int items = N / 32, start = (vcu + G - (off % G)) % G;
    const int w = __builtin_amdgcn_readfirstlane(tid >> 6), lane = tid & 63, r = lane >> 3, c = lane & 7;
    LAS float* cml = (LAS float*)(lds + QW_CM);
    for (int it = start; it < items; it += G) { const int n0 = it * 32;
        const int orow0 = (mode == 0) ? n0 : 256 * (n0 >> 7) + 128 * (mode - 1) + (n0 & 127);
        const float* src = W + (size_t)(128 * w + 4 * r) * N + n0 + 4 * c;
        f32x4 v[16];
#pragma unroll
        for (int b = 0; b < 4; ++b)
#pragma unroll
            for (int dk = 0; dk < 4; ++dk) v[4 * b + dk] = *(const f32x4*)(src + (size_t)(32 * b + dk) * N);
        f32x4 m = {0.f, 0.f, 0.f, 0.f};
#pragma unroll
        for (int i = 0; i < 16; ++i) { m.x = fmaxf(m.x, fabsf(v[i].x)); m.y = fmaxf(m.y, fabsf(v[i].y)); m.z = fmaxf(m.z, fabsf(v[i].z)); m.w = fmaxf(m.w, fabsf(v[i].w)); }
#pragma unroll
        for (int o = 8; o < 64; o <<= 1) { m.x = fmaxf(m.x, __shfl_xor(m.x, o)); m.y = fmaxf(m.y, __shfl_xor(m.y, o)); m.z = fmaxf(m.z, __shfl_xor(m.z, o)); m.w = fmaxf(m.w, __shfl_xor(m.w, o)); }
        if (r == 0) *(LAS f32x4*)(cml + w * 32 + 4 * c) = m;
        __syncthreads();
        f32x4 mx = *(const LAS f32x4*)(cml + 4 * c);
#pragma unroll
        for (int ww = 1; ww < 8; ++ww) { const f32x4 t = *(const LAS f32x4*)(cml + ww * 32 + 4 * c); mx.x = fmaxf(mx.x, t.x); mx.y = fmaxf(mx.y, t.y); mx.z = fmaxf(mx.z, t.z); mx.w = fmaxf(mx.w, t.w); }
        if (w == 0 && r == 0) *(f32x4*)(cm + orow0 + 4 * c) = mx;
        const f32x4 inv = {mx.x > 0.f ? 127.f / mx.x : 0.f, mx.y > 0.f ? 127.f / mx.y : 0.f, mx.z > 0.f ? 127.f / mx.z : 0.f, mx.w > 0.f ? 127.f / mx.w : 0.f};
        LAS unsigned char* img = lds + QW_BUF + 128 * w + 4 * r;
#pragma unroll
        for (int b = 0; b < 4; ++b) {
#define QW_PK(comp_, j_) { const int q0 = (int)rintf(v[4 * b].comp_ * inv.comp_), q1 = (int)rintf(v[4 * b + 1].comp_ * inv.comp_), q2 = (int)rintf(v[4 * b + 2].comp_ * inv.comp_), q3 = (int)rintf(v[4 * b + 3].comp_ * inv.comp_); \
            *(LAS unsigned*)(img + (4 * c + j_) * QW_STRIDE + 32 * b) = (unsigned)(q0 & 255) | ((unsigned)(q1 & 255) << 8) | ((unsigned)(q2 & 255) << 16) | ((unsigned)(q3 & 255) << 24); }
            QW_PK(x, 0) QW_PK(y, 1) QW_PK(z, 2) QW_PK(w, 3)
#undef QW_PK
        }
        __syncthreads();
        { const int n = tid >> 4, ch = tid & 15; const LAS u32x4* sp = (const LAS u32x4*)(lds + QW_BUF + n * QW_STRIDE + ch * 64); u32x4* dp = (u32x4*)(WT + (size_t)(orow0 + n) * 1024 + ch * 64);
          const u32x4 x0 = sp[0], x1 = sp[1], x2 = sp[2], x3 = sp[3]; dp[0] = x0; dp[1] = x1; dp[2] = x2; dp[3] = x3; }
        __syncthreads();
    }
    off += items;
}

struct Args { const float* in[25]; float* out; unsigned char* ws; int pad0, pad1; };
typedef const Args __attribute__((address_space(4))) KArgs;
__device__ __forceinline__ KArgs* KA() { KArgs* p = (KArgs*)__builtin_amdgcn_kernarg_segment_ptr(); asm volatile("" : "+s"(p)); return p; }
struct Ctx {
    float* out; unsigned char* ws;
    int tid, lane, wave, vcu, G, gw, NGW;
    LAS unsigned char* lds;
};
enum { I_X = 0, I_C, I_CTX, I_CCTX, I_WADA, I_BADA, I_NORM1, I_WIN, I_QLN, I_KVLN, I_WUQ, I_WUKV, I_QN, I_KN, I_ONA, I_ONF, I_WOUT, I_NORM2, I_FG, I_FU, I_FD, I_WR, I_MG, I_MU, I_MD };

__device__ __forceinline__ void conv_dense_weights(const Ctx& C) {
    KArgs* A = KA();
    LAS float* scr = (LAS float*)(C.lds + C.wave * 8448); int off = 0;
    for (int l = 0; l < DEPTH; ++l) {
        conv_mat(A->in[I_WUQ] + (size_t)l * 256 * 768, 256, 768, (bf16_t*)(C.ws + WS_WUQ) + (size_t)l * 768 * 256, 0, A->in[I_QLN] + l * 256, off, C.gw, C.NGW, scr, C.lane);
        conv_mat(A->in[I_WUKV] + (size_t)l * 256 * 1024, 256, 1024, (bf16_t*)(C.ws + WS_WUKV) + (size_t)l * 1024 * 256, 0, A->in[I_KVLN] + l * 256, off, C.gw, C.NGW, scr, C.lane);
    }
    for (int i = 0; i < 2; ++i) {
        conv_mat_f8(A->in[I_FD] + (size_t)i * FFN * DM, FFN, DM, (unsigned char*)(C.ws + WS_WD) + (size_t)i * DM * FFN, WD_SCALE, off, C.gw, C.NGW, scr, C.lane);
    }
    for (int l = 0; l < DEPTH; ++l) { u32x4* z = (u32x4*)((signed char*)(C.ws + WS_WIN) + ((size_t)l * 1280 + INW) * DM);
        for (int i = C.gw * 64 + C.lane; i < 224 * DM / 16; i += C.NGW * 64) z[i] = (u32x4){0u, 0u, 0u, 0u}; }
}
__device__ __forceinline__ void conv_moe(const Ctx& C, int i) {
    KArgs* A = KA();
    LAS float* scr = (LAS float*)(C.lds + C.wave * 8448); int off = 0, offw = 0;
    float* cm = (float*)(C.ws + WS_SCL + SCL_SWM) + (size_t)i * 8 * 7168;
    for (int e = 0; e < NE; ++e) {
        const size_t wo = ((size_t)i * NE + e) * DM * MFF;
        quant_wg(A->in[I_MG] + wo, MFF, (signed char*)(C.ws + WS_MGU) + (size_t)e * 7168 * DM, cm + e * 7168, 1, offw, C.vcu, C.G, C.lds, C.tid);
        quant_wg(A->in[I_MU] + wo, MFF, (signed char*)(C.ws + WS_MGU) + (size_t)e * 7168 * DM, cm + e * 7168, 2, offw, C.vcu, C.G, C.lds, C.tid);
    }
    for (int e = 0; e < NE; ++e) {
        const size_t wo = ((size_t)i * NE + e) * DM * MFF;
        conv_mat_f8(A->in[I_MD] + wo, MFF, DM, (unsigned char*)(C.ws + WS_MD) + (size_t)e * DM * MFF, WD_SCALE, off, C.gw, C.NGW, scr, C.lane);
    }
}
__device__ __forceinline__ void conv_gu(const Ctx& C) {
    KArgs* A = KA(); int offw = 0;
    for (int i = 0; i < 2; ++i) { float* cm = (float*)(C.ws + WS_SCL + SCL_SWD) + i * 5632;
        quant_wg(A->in[I_FG] + (size_t)i * DM * FFN, FFN, (signed char*)(C.ws + WS_WGU) + (size_t)i * 5632 * DM, cm, 1, offw, C.vcu, C.G, C.lds, C.tid);
        quant_wg(A->in[I_FU] + (size_t)i * DM * FFN, FFN, (signed char*)(C.ws + WS_WGU) + (size_t)i * 5632 * DM, cm, 2, offw, C.vcu, C.G, C.lds, C.tid); }
    for (int l = 0; l < DEPTH; ++l) quant_wg(A->in[I_WOUT] + (size_t)l * DM * DM, DM, (signed char*)(C.ws + WS_WOUT) + (size_t)l * DM * DM, (float*)(C.ws + WS_SCL + SCL_SWO) + l * DM, 0, offw, C.vcu, C.G, C.lds, C.tid);
    for (int l = 0; l < DEPTH; ++l) quant_wg(A->in[I_WIN] + (size_t)l * DM * INW, INW, (signed char*)(C.ws + WS_WIN) + (size_t)l * 1280 * DM, (float*)(C.ws + WS_SCL + SCL_SWI) + l * 1280, 0, offw, C.vcu, C.G, C.lds, C.tid);
}
__device__ __forceinline__ void ada_phase(const Ctx& C) {
    KArgs* A = KA();
    LAS float* sl = (LAS float*)C.lds; LAS float* red = sl + 5 * 1024;
    for (int i = C.tid; i < 5 * 1024; i += 512) { const int r = i >> 10, k = i & 1023; const float v = (r < 4) ? A->in[I_C][r * 1024 + k] : A->in[I_CCTX][k]; sl[i] = v / (1.f + expf(-v)); }
    __syncthreads();
    float* mod = (float*)(C.ws + WS_MOD);
    for (int it = C.vcu; it < 4 * 64; it += C.G) { const int l = it >> 6, n0 = (it & 63) * 96, col = C.tid & 127, kq = C.tid >> 7; const int cc_ = col < 96 ? col : 95;
        const float* w = A->in[I_WADA] + ((size_t)l * DM + kq * 256) * 6144 + n0 + cc_; const LAS float* s = sl + kq * 256;
        float a0 = 0.f, a1 = 0.f, a2 = 0.f, a3 = 0.f, a4 = 0.f;
        for (int k = 0; k < 256; k += 16) { float wv[16];
#pragma unroll
            for (int j = 0; j < 16; ++j) wv[j] = w[(size_t)(k + j) * 6144];
#pragma unroll
            for (int j = 0; j < 16; ++j) { a0 += s[k + j] * wv[j]; a1 += s[1024 + k + j] * wv[j]; a2 += s[2048 + k + j] * wv[j]; a3 += s[3072 + k + j] * wv[j]; a4 += s[4096 + k + j] * wv[j]; } }
        red[(kq * 5 + 0) * 128 + col] = a0; red[(kq * 5 + 1) * 128 + col] = a1; red[(kq * 5 + 2) * 128 + col] = a2; red[(kq * 5 + 3) * 128 + col] = a3; red[(kq * 5 + 4) * 128 + col] = a4;
        __syncthreads();
        for (int i = C.tid; i < 5 * 128; i += 512) { const int r = i >> 7, cc = i & 127; if (cc >= 96) continue;
            mod[((size_t)l * 5 + r) * 6144 + n0 + cc] = ((red[(0 * 5 + r) * 128 + cc] + red[(1 * 5 + r) * 128 + cc]) + (red[(2 * 5 + r) * 128 + cc] + red[(3 * 5 + r) * 128 + cc])) + A->in[I_BADA][l * 6144 + n0 + cc]; }
        __syncthreads();
    }
}
__device__ __forceinline__ size_t res_row_off(int row, int& mr, bool& isctx) {
    const int b = row / SB, j = row - b * SB; isctx = j >= SEQ; mr = isctx ? 4 : b;
    return isctx ? ((size_t)b * CTXL + (j - SEQ)) * DM : ((size_t)b * SEQ + j) * DM;
}
template <bool F32> __device__ __forceinline__ f32x4 ld4(const void* rowp, int idx) {
    if constexpr (F32) return ((const f32x4*)rowp)[idx];
    else { const u32x2 v = ((const u32x2*)rowp)[idx]; return (f32x4){bflo(v.x), bfhi(v.x), bflo(v.y), bfhi(v.y)}; }
}
template <bool F32> __device__ __forceinline__ void st4(void* rowp, int idx, f32x4 v) {
    if constexpr (F32) ((f32x4*)rowp)[idx] = v; else ((u32x2*)rowp)[idx] = (u32x2){pk2(v.x, v.y), pk2(v.z, v.w)};
}
template <bool ROUTE, bool I8OUT, bool SRC_F32>
__device__ __forceinline__ void norm_phase(const Ctx& C, const void* lat, const void* ctx, const float* gain, const float* modl, int shift_off, int scale_off, bool with_ctx, const float* wr, bf16_t* ctx_copy = nullptr, int nparts = 0) {
    bf16_t* H = (bf16_t*)(C.ws + WS_H);
    LAS float* wrl = (LAS float*)C.lds;
    LAS int* le = (LAS int*)(C.lds + 32768);
    int* RE = (int*)(C.ws + WS_META + MT_RE); float* RW = (float*)(C.ws + WS_META + MT_RW); int* LR = (int*)(C.ws + WS_META + MT_LR); int* BC = (int*)(C.ws + WS_META + MT_BC);
    if (ROUTE) { for (int i = C.tid; i < 8192; i += 512) wrl[i] = wr[i]; __syncthreads(); }
    f32x4 wreg[4][8];
    if (ROUTE) {
#pragma unroll
        for (int j = 0; j < 4; ++j)
#pragma unroll
            for (int q = 0; q < 8; ++q) wreg[j][q] = *(const LAS f32x4*)(wrl + (4 * C.lane + 256 * j) * 8 + 4 * q); }
    const int chunk = TT / 256, row0 = blockIdx.x * chunk;
    for (int rr = C.wave; rr < chunk; rr += 8) {
        const int row = row0 + rr; int mr; bool isctx; const size_t ro = res_row_off(row, mr, isctx);
        const unsigned char* xr = (const unsigned char*)(isctx ? ctx : lat) + ro * (SRC_F32 ? 4 : 2);
        if (isctx && !with_ctx) { if (ROUTE && C.lane == 0) { le[rr * 2] = -1; le[rr * 2 + 1] = -1; RE[row * 2] = -1; RE[row * 2 + 1] = -1; } continue; }
        f32x4 v[4]; float ss = 0.f;
#pragma unroll
        for (int j = 0; j < 4; ++j) { v[j] = ld4<SRC_F32>(xr, C.lane + 64 * j); ss += (v[j].x * v[j].x + v[j].y * v[j].y) + (v[j].z * v[j].z + v[j].w * v[j].w); }
        if (ctx_copy && isctx) {
            const float* cp = (const float*)(C.ws + WS_CPART) + ro;
            for (int p = 0; p < nparts; ++p) { const f32x4* pv = (const f32x4*)(cp + (size_t)p * NB * CTXL * DM) + C.lane;
#pragma unroll
                for (int j = 0; j < 4; ++j) v[j] = v[j] + pv[64 * j]; }
            ss = 0.f;
#pragma unroll
            for (int j = 0; j < 4; ++j) { st4<false>(ctx_copy + ro, C.lane + 64 * j, v[j]); ss += (v[j].x * v[j].x + v[j].y * v[j].y) + (v[j].z * v[j].z + v[j].w * v[j].w); } }
        const float rinv = rsqrtf(wave_sum(ss) * (1.f / DM) + EPS);
        const f32x4* gv = (const f32x4*)gain + C.lane; const f32x4* shv = (const f32x4*)(modl + (size_t)mr * 6144 + shift_off) + C.lane; const f32x4* scv = (const f32x4*)(modl + (size_t)mr * 6144 + scale_off) + C.lane;
        u32x2* o8 = (u32x2*)(H + (size_t)row * DM) + C.lane;
        unsigned* o4 = (unsigned*)((signed char*)H + (size_t)row * DM) + C.lane;
        f32x4 hq[4]; float amax = 0.f;
        float lg[8];
        if (ROUTE) {
#pragma unroll
            for (int e = 0; e < 8; ++e) lg[e] = 0.f; }
#pragma unroll
        for (int j = 0; j < 4; ++j) { const f32x4 g = gv[64 * j], sh = shv[64 * j], sc = scv[64 * j];
            const f32x4 y = (v[j] * rinv) * g; const f32x4 h = y * (sc + 1.f) + sh;
            if (I8OUT) { hq[j] = h; amax = fmaxf(fmaxf(amax, fmaxf(fabsf(h.x), fabsf(h.y))), fmaxf(fabsf(h.z), fabsf(h.w))); } else o8[64 * j] = (u32x2){pk2(h.x, h.y), pk2(h.z, h.w)};
            if (ROUTE) {
#pragma unroll
                for (int e = 0; e < 8; ++e) lg[e] += (h.x * wreg[j][e >> 2][e & 3] + h.y * wreg[j][2 + (e >> 2)][e & 3]) + (h.z * wreg[j][4 + (e >> 2)][e & 3] + h.w * wreg[j][6 + (e >> 2)][e & 3]); } }
        if (I8OUT) {
#pragma unroll
            for (int o = 1; o < 64; o <<= 1) amax = fmaxf(amax, __shfl_xor(amax, o));
            const float inv = amax > 0.f ? 127.f / amax : 0.f;
            if (C.lane == 0) ((float*)(C.ws + WS_META + MT_SH))[row] = amax * (1.f / 127.f);
#pragma unroll
            for (int j = 0; j < 4; ++j) { const int a = (int)rintf(hq[j].x * inv), b = (int)rintf(hq[j].y * inv), c = (int)rintf(hq[j].z * inv), d = (int)rintf(hq[j].w * inv);
                o4[64 * j] = (unsigned)(a & 255) | ((unsigned)(b & 255) << 8) | ((unsigned)(c & 255) << 16) | ((unsigned)(d & 255) << 24); } }
        if (ROUTE) {
#pragma unroll
            for (int e = 0; e < 8; ++e) lg[e] = wave_sum(lg[e]);
            int e1 = 0; float l1 = lg[0];
#pragma unroll
            for (int e = 1; e < 8; ++e) if (lg[e] > l1) { l1 = lg[e]; e1 = e; }
            int e2 = -1; float l2 = -3.0e38f;
#pragma unroll
            for (int e = 0; e < 8; ++e) if (e != e1 && lg[e] > l2) { l2 = lg[e]; e2 = e; }
            if (C.lane == 0) { const float w2 = 1.f / (1.f + expf(l1 - l2)), w1 = 1.f - w2; le[rr * 2] = e1; le[rr * 2 + 1] = e2; RE[row * 2] = e1; RE[row * 2 + 1] = e2; RW[row * 2] = w1; RW[row * 2 + 1] = w2; }
        }
    }
    if (ROUTE) {
        __syncthreads();
        LAS int* lr = le + 264;
        if (C.tid < 8) { int cnt = 0; for (int i = 0; i < chunk * 2; ++i) if (le[i] == C.tid) lr[i] = cnt++; BC[blockIdx.x * 8 + C.tid] = cnt; }
        __syncthreads();
        for (int i = C.tid; i < chunk * 2; i += 512) LR[row0 * 2 + i] = (le[i] >= 0) ? lr[i] : 0;
        __syncthreads();
    }
}
__device__ __forceinline__ void qkpost_phase(const Ctx& C, const float* qn, const float* kn, bool ctx_q) {
    const bf16_t* P = (const bf16_t*)(C.ws + WS_P); const bf16_t* QR = (const bf16_t*)(C.ws + WS_QRAW); const bf16_t* KVR = (const bf16_t*)(C.ws + WS_KVRAW);
    unsigned char* Q = C.ws + WS_Q; unsigned char* K = C.ws + WS_K; unsigned char* V = C.ws + WS_V;
    const int lane = C.lane, h = lane >> 3, s = lane & 7;
    const int rb1 = (s < 4) ? 64 : 80, i0 = (2 * s) & 7;
    float gq[12], gk[12];
#pragma unroll
    for (int j = 0; j < 8; ++j) { gq[j] = qn[8 * s + j]; gk[j] = kn[8 * s + j]; }
    gq[8] = qn[rb1 + i0]; gq[9] = qn[rb1 + i0 + 1]; gq[10] = qn[rb1 + 8 + i0]; gq[11] = qn[rb1 + 8 + i0 + 1];
    gk[8] = kn[rb1 + i0]; gk[9] = kn[rb1 + i0 + 1]; gk[10] = kn[rb1 + 8 + i0]; gk[11] = kn[rb1 + 8 + i0 + 1];
    const float if0 = powf(10000.f, -(float)i0 * 0.125f), if1 = powf(10000.f, -(float)(i0 + 1) * 0.125f);
    for (int grp = C.gw; grp < TT / 4; grp += C.NGW) {
      const int row0 = grp * 4, b = row0 / SB, j0 = row0 - b * SB; const bool isctx = j0 >= SEQ;
      float vprev[8]; int vacc[8];
#pragma unroll
      for (int i = 0; i < 8; ++i) { vprev[i] = 0.f; vacc[i] = 0; }
#pragma unroll
      for (int rr = 0; rr < 4; ++rr) {
        const int row = row0 + rr, j = j0 + rr;
        const bf16_t* pr = P + (size_t)row * INW;
        const u32x2 cq = *(const u32x2*)(pr + 4 * lane), ckv = *(const u32x2*)(pr + 256 + 4 * lane);
        float sq = bflo(cq.x) * bflo(cq.x) + bfhi(cq.x) * bfhi(cq.x) + bflo(cq.y) * bflo(cq.y) + bfhi(cq.y) * bfhi(cq.y);
        float sk = bflo(ckv.x) * bflo(ckv.x) + bfhi(ckv.x) * bfhi(ckv.x) + bflo(ckv.y) * bflo(ckv.y) + bfhi(ckv.y) * bfhi(ckv.y);
        const float aq = rsqrtf(wave_sum(sq) * (1.f / 256.f) + EPS), akv = rsqrtf(wave_sum(sk) * (1.f / 256.f) + EPS);
        float cs0 = 1.f, sn0 = 0.f, cs1 = 1.f, sn1 = 0.f;
        if (!isctx) { const float pos = (s < 4) ? (float)(j >> 6) : (float)(j & 63); sincosf(pos * if0, &sn0, &cs0); sincosf(pos * if1, &sn1, &cs1); }
        { const bf16_t* kvr = KVR + (size_t)row * 1024 + h * 128;
          const u32x4 kn8 = *(const u32x4*)(kvr + 8 * s), vv8 = *(const u32x4*)(kvr + 64 + 8 * s);
          const unsigned pe1 = *(const unsigned*)(pr + 512 + (rb1 - 64) + i0), pe2 = *(const unsigned*)(pr + 512 + (rb1 - 64) + 8 + i0);
          float x[12]; x[0] = bflo(kn8.x) * akv; x[1] = bfhi(kn8.x) * akv; x[2] = bflo(kn8.y) * akv; x[3] = bfhi(kn8.y) * akv; x[4] = bflo(kn8.z) * akv; x[5] = bfhi(kn8.z) * akv; x[6] = bflo(kn8.w) * akv; x[7] = bfhi(kn8.w) * akv;
          x[8] = bflo(pe1); x[9] = bfhi(pe1); x[10] = bflo(pe2); x[11] = bfhi(pe2);
          float ss = 0.f;
#pragma unroll
          for (int i = 0; i < 12; ++i) ss += x[i] * x[i];
          ss += __shfl_xor(ss, 1); ss += __shfl_xor(ss, 2); ss += __shfl_xor(ss, 4);
          const float rn = rsqrtf(ss * (1.f / 96.f) + EPS);
#pragma unroll
          for (int i = 0; i < 12; ++i) x[i] = x[i] * rn * gk[i];
          const float r0 = x[8] * cs0 - x[10] * sn0, r1 = x[9] * cs1 - x[11] * sn1, r2 = x[8] * sn0 + x[10] * cs0, r3 = x[9] * sn1 + x[11] * cs1;
          unsigned char* ko = K + (size_t)row * 768 + h * 96;
          *(u32x2*)(ko + 8 * s) = (u32x2){pk4f8(x[0], x[1], x[2], x[3]), pk4f8(x[4], x[5], x[6], x[7])};
          *(unsigned short*)(ko + rb1 + i0) = (unsigned short)pk4f8(r0, r1, 0.f, 0.f); *(unsigned short*)(ko + rb1 + 8 + i0) = (unsigned short)pk4f8(r2, r3, 0.f, 0.f);
          const float vf[8] = {c448(bflo(vv8.x) * akv), c448(bfhi(vv8.x) * akv), c448(bflo(vv8.y) * akv), c448(bfhi(vv8.y) * akv), c448(bflo(vv8.z) * akv), c448(bfhi(vv8.z) * akv), c448(bflo(vv8.w) * akv), c448(bfhi(vv8.w) * akv)};
#pragma unroll
          for (int i = 0; i < 8; ++i) { if (rr == 1) vacc[i] = __builtin_amdgcn_cvt_pk_fp8_f32(vprev[i], vf[i], vacc[i], false); else if (rr == 3) vacc[i] = __builtin_amdgcn_cvt_pk_fp8_f32(vprev[i], vf[i], vacc[i], true); else vprev[i] = vf[i]; } }
        if (!isctx || ctx_q) {
          const bf16_t* qr = QR + (size_t)row * 768 + h * 96;
          const u32x4 q8 = *(const u32x4*)(qr + 8 * s); const unsigned q1 = *(const unsigned*)(qr + rb1 + i0), q2 = *(const unsigned*)(qr + rb1 + 8 + i0);
          float x[12]; x[0] = bflo(q8.x); x[1] = bfhi(q8.x); x[2] = bflo(q8.y); x[3] = bfhi(q8.y); x[4] = bflo(q8.z); x[5] = bfhi(q8.z); x[6] = bflo(q8.w); x[7] = bfhi(q8.w);
          x[8] = bflo(q1); x[9] = bfhi(q1); x[10] = bflo(q2); x[11] = bfhi(q2);
          float ss = 0.f;
#pragma unroll
          for (int i = 0; i < 12; ++i) { x[i] *= aq; ss += x[i] * x[i]; }
          ss += __shfl_xor(ss, 1); ss += __shfl_xor(ss, 2); ss += __shfl_xor(ss, 4);
          const float rn = rsqrtf(ss * (1.f / 96.f) + EPS) * QSCALE;
#pragma unroll
          for (int i = 0; i < 12; ++i) x[i] = x[i] * rn * gq[i];
          const float r0 = x[8] * cs0 - x[10] * sn0, r1 = x[9] * cs1 - x[11] * sn1, r2 = x[8] * sn0 + x[10] * cs0, r3 = x[9] * sn1 + x[11] * cs1;
          unsigned char* qo = Q + (size_t)row * 768 + h * 96;
          *(u32x2*)(qo + 8 * s) = (u32x2){pk4f8(x[0], x[1], x[2], x[3]), pk4f8(x[4], x[5], x[6], x[7])};
          *(unsigned short*)(qo + rb1 + i0) = (unsigned short)pk4f8(r0, r1, 0.f, 0.f); *(unsigned short*)(qo + rb1 + 8 + i0) = (unsigned short)pk4f8(r2, r3, 0.f, 0.f); }
      }
      unsigned char* vo = V + ((size_t)(b * NH + h) * (SB / 64) + (j0 >> 6)) * 4096 + (8 * s) * 64 + (j0 & 63);
#pragma unroll
      for (int i = 0; i < 8; ++i) *(unsigned*)(vo + i * 64) = (unsigned)vacc[i];
    }
}
__device__ __forceinline__ void mixnorm_phase(const Ctx& C, const float* ga, const float* gf, bool with_ctx) {
    const bf16_t* AT = (const bf16_t*)(C.ws + WS_ATT); const bf16_t* FO = (const bf16_t*)(C.ws + WS_FOUR); signed char* H8 = (signed char*)(C.ws + WS_H); float* SH = (float*)(C.ws + WS_META + MT_SH);
    const int lane = C.lane;
    const f32x4 ga0 = *(const f32x4*)(ga + 8 * lane), ga1 = *(const f32x4*)(ga + 8 * lane + 4), gf0 = *(const f32x4*)(gf + 8 * lane), gf1 = *(const f32x4*)(gf + 8 * lane + 4);
    for (int row = C.gw; row < TT; row += C.NGW) {
        if (!with_ctx && (row % SB) >= SEQ) continue;
        const u32x4 a = *(const u32x4*)(AT + (size_t)row * 512 + 8 * lane), f = *(const u32x4*)(FO + (size_t)row * 512 + 8 * lane);
        float xa[8] = {bflo(a.x), bfhi(a.x), bflo(a.y), bfhi(a.y), bflo(a.z), bfhi(a.z), bflo(a.w), bfhi(a.w)}, xf[8] = {bflo(f.x), bfhi(f.x), bflo(f.y), bfhi(f.y), bflo(f.z), bfhi(f.z), bflo(f.w), bfhi(f.w)};
        float sa = 0.f, sf = 0.f;
#pragma unroll
        for (int i = 0; i < 8; ++i) { sa += xa[i] * xa[i]; sf += xf[i] * xf[i]; }
        const float ra = rsqrtf(wave_sum(sa) * (1.f / 512.f) + EPS), rf = rsqrtf(wave_sum(sf) * (1.f / 512.f) + EPS);
        float amax = 0.f;
#pragma unroll
        for (int i = 0; i < 4; ++i) { xa[i] = xa[i] * ra * ga0[i]; xa[4 + i] = xa[4 + i] * ra * ga1[i]; xf[i] = xf[i] * rf * gf0[i]; xf[4 + i] = xf[4 + i] * rf * gf1[i]; }
#pragma unroll
        for (int i = 0; i < 8; ++i) amax = fmaxf(amax, fmaxf(fabsf(xa[i]), fabsf(xf[i])));
#pragma unroll
        for (int o = 1; o < 64; o <<= 1) amax = fmaxf(amax, __shfl_xor(amax, o));
        const float inv = amax > 0.f ? 127.f / amax : 0.f;
        if (lane == 0) SH[row] = amax * (1.f / 127.f);
        unsigned qa[2], qf[2];
#pragma unroll
        for (int i = 0; i < 2; ++i) { qa[i] = ((unsigned)((int)rintf(xa[4 * i] * inv) & 255)) | ((unsigned)((int)rintf(xa[4 * i + 1] * inv) & 255) << 8) | ((unsigned)((int)rintf(xa[4 * i + 2] * inv) & 255) << 16) | ((unsigned)((int)rintf(xa[4 * i + 3] * inv) & 255) << 24);
            qf[i] = ((unsigned)((int)rintf(xf[4 * i] * inv) & 255)) | ((unsigned)((int)rintf(xf[4 * i + 1] * inv) & 255) << 8) | ((unsigned)((int)rintf(xf[4 * i + 2] * inv) & 255) << 16) | ((unsigned)((int)rintf(xf[4 * i + 3] * inv) & 255) << 24); }
        signed char* o = H8 + (size_t)row * DM + 8 * lane;
        *(u32x2*)o = (u32x2){qa[0], qa[1]}; *(u32x2*)(o + 512) = (u32x2){qf[0], qf[1]};
    }
}
__device__ __forceinline__ void moe_assign_phase(const Ctx& C) {
    const int* RE = (const int*)(C.ws + WS_META + MT_RE); const int* LR = (const int*)(C.ws + WS_META + MT_LR); const int* BC = (const int*)(C.ws + WS_META + MT_BC);
    int* TS = (int*)(C.ws + WS_META + MT_TS); int* TE = (int*)(C.ws + WS_META + MT_TE); int* NTP = (int*)(C.ws + WS_META + MT_NT);
    LAS int* bc = (LAS int*)C.lds; LAS int* base = bc + 2048;
    for (int i = C.tid; i < 2048; i += 512) bc[i] = BC[i];
    __syncthreads();
    if (C.tid < 8) { int pre = 0, tot = 0; for (int b = 0; b < 256; ++b) { const int v = bc[b * 8 + C.tid]; if (b < (int)blockIdx.x) pre += v; tot += v; } base[C.tid] = pre; base[8 + C.tid] = tot; }
    __syncthreads();
    if (C.tid == 0) { int run = 0; for (int e = 0; e < 8; ++e) { const int tot = base[8 + e], tiles = (tot + 255) >> 8;
            if (blockIdx.x == 0) for (int t = 0; t < tiles; ++t) TE[(run >> 8) + t] = e;
            base[e] += run; run += tiles << 8; }
        if (blockIdx.x == 0) NTP[0] = run >> 8; }
    __syncthreads();
    const bf16_t* H = (const bf16_t*)(C.ws + WS_H); bf16_t* AM = (bf16_t*)(C.ws + WS_AMOE);
    const int chunk = TT / 256, row0 = blockIdx.x * chunk;
    for (int rr = C.wave; rr < chunk; rr += 8) { const int row = row0 + rr;
#pragma unroll
        for (int k = 0; k < 2; ++k) { const int e = RE[row * 2 + k]; if (e < 0) { if (C.lane == 0) TS[row * 2 + k] = -1; continue; }
            const int slot = base[e] + LR[row * 2 + k]; if (C.lane == 0) TS[row * 2 + k] = slot;
            const u32x4* src = (const u32x4*)((const signed char*)H + (size_t)row * DM) + C.lane; u32x4* dst = (u32x4*)((signed char*)AM + (size_t)slot * DM) + C.lane;
            dst[0] = src[0]; if (C.lane == 0) ((float*)(C.ws + WS_META + MT_SA))[slot] = ((const float*)(C.ws + WS_META + MT_SH))[row]; } }
}
template <bool FUSE_N1, bool DST_F32> __device__ __forceinline__ void moe_combine_phase(const Ctx& C, bf16_t* lat, bf16_t* ctx, float* out32, const float* modl, int gate_off, const float* gain_n = nullptr, const float* modn = nullptr) {
    const int* TS = (const int*)(C.ws + WS_META + MT_TS); const float* RW = (const float*)(C.ws + WS_META + MT_RW); const bf16_t* Y = (const bf16_t*)(C.ws + WS_Y);
    for (int row = C.gw; row < TT; row += C.NGW) {
        const int s0 = TS[row * 2], s1 = TS[row * 2 + 1]; if (s0 < 0) continue;
        int mr; bool isctx; const size_t ro = res_row_off(row, mr, isctx); bf16_t* xr = (isctx ? ctx : lat) + ro;
        const float w0 = RW[row * 2] * DOWN_OSCALE, w1 = RW[row * 2 + 1] * DOWN_OSCALE;
        const f32x4* gv = (const f32x4*)(modl + (size_t)mr * 6144 + gate_off) + C.lane;
        const u32x2* y0 = (const u32x2*)(Y + (size_t)s0 * DM) + C.lane; const u32x2* y1 = (const u32x2*)(Y + (size_t)s1 * DM) + C.lane;
        f32x4 xs[4]; float ss = 0.f;
#pragma unroll
        for (int j = 0; j < 4; ++j) { const u32x2 a = y0[64 * j], b = y1[64 * j]; const f32x4 g = gv[64 * j]; f32x4 x = ld4<false>(xr, C.lane + 64 * j);
            x.x += g.x * (w0 * bflo(a.x) + w1 * bflo(b.x)); x.y += g.y * (w0 * bfhi(a.x) + w1 * bfhi(b.x)); x.z += g.z * (w0 * bflo(a.y) + w1 * bflo(b.y)); x.w += g.w * (w0 * bfhi(a.y) + w1 * bfhi(b.y));
            if constexpr (DST_F32) st4<true>(out32 + ro, C.lane + 64 * j, x); else st4<false>(xr, C.lane + 64 * j, x);
            xs[j] = x; ss += (x.x * x.x + x.y * x.y) + (x.z * x.z + x.w * x.w); }
        if constexpr (FUSE_N1) {
            const float rinv = rsqrtf(wave_sum(ss) * (1.f / DM) + EPS);
            const f32x4* gn = (const f32x4*)gain_n + C.lane; const f32x4* shv = (const f32x4*)(modn + (size_t)mr * 6144) + C.lane; const f32x4* scv = (const f32x4*)(modn + (size_t)mr * 6144 + 1024) + C.lane;
            float amax = 0.f;
#pragma unroll
            for (int j = 0; j < 4; ++j) { const f32x4 h = ((xs[j] * rinv) * gn[64 * j]) * (scv[64 * j] + 1.f) + shv[64 * j]; xs[j] = h; amax = fmaxf(fmaxf(amax, fmaxf(fabsf(h.x), fabsf(h.y))), fmaxf(fabsf(h.z), fabsf(h.w))); }
#pragma unroll
            for (int o = 1; o < 64; o <<= 1) amax = fmaxf(amax, __shfl_xor(amax, o));
            const float inv = amax > 0.f ? 127.f / amax : 0.f;
            if (C.lane == 0) ((float*)(C.ws + WS_META + MT_SH))[row] = amax * (1.f / 127.f);
            unsigned* o4 = (unsigned*)((signed char*)(C.ws + WS_H) + (size_t)row * DM) + C.lane;
#pragma unroll
            for (int j = 0; j < 4; ++j) { const int a = (int)rintf(xs[j].x * inv), b = (int)rintf(xs[j].y * inv), c = (int)rintf(xs[j].z * inv), d = (int)rintf(xs[j].w * inv);
                o4[64 * j] = (unsigned)(a & 255) | ((unsigned)(b & 255) << 8) | ((unsigned)(c & 255) << 16) | ((unsigned)(d & 255) << 24); } }
    }
}
#ifndef R_ATT
#define R_ATT 1
#endif
#ifndef R_MOE
#define R_MOE 1
#endif
#ifndef R_PROJ
#define R_PROJ 1
#endif
#ifndef R_GU
#define R_GU 1
#endif
#ifndef R_BAR
#define R_BAR 1
#endif
#ifndef R_N1
#define R_N1 1
#endif
#ifndef R_F1
#define R_F1 1
#endif
#ifndef R_QK
#define R_QK 1
#endif
#ifndef R_F2
#define R_F2 1
#endif
#ifndef R_MX
#define R_MX 1
#endif
#ifndef R_CF
#define R_CF 1
#endif
#ifndef R_CMB
#define R_CMB 1
#endif
#ifndef R_MISC
#define R_MISC 1
#endif
#ifndef R_PRO
#define R_PRO 1
#endif
#ifndef R_N2
#define R_N2 1
#endif
#ifndef R_ASG
#define R_ASG 1
#endif
#ifndef R_CV3
#define R_CV3 1
#endif

#define GRID_BAR() do { XcdBarrier b_; b_.bar = (unsigned*)(KA()->ws + WS_CTL); b_.x = xb_xcc_id(); b_.st = (volatile LAS unsigned*)(lds + MISC_OFF) + 8; for (int rb_ = 0; rb_ < R_BAR; ++rb_) xcd_barrier(b_); } while (0)
#define PHASE_CTX() Ctx C; { KArgs* ka_ = KA(); C.out = ka_->out; C.ws = ka_->ws; C.lds = lds; C.tid = otid(); C.lane = C.tid & 63; C.wave = __builtin_amdgcn_readfirstlane(C.tid >> 6); \
        C.G = gridDim.x; const int bx_ = blockIdx.x; C.vcu = (C.G % 8 == 0) ? (bx_ % 8) * (C.G / 8) + bx_ / 8 : bx_; C.gw = C.vcu * 8 + C.wave; C.NGW = C.G * 8; } \
        unsigned char* ws = C.ws; float* mod = (float*)(ws + WS_MOD); bf16_t* ctxs = (bf16_t*)(ws + WS_XCB); bf16_t* xb = (bf16_t*)(ws + WS_XB); bf16_t* H = (bf16_t*)(ws + WS_H); bf16_t* P = (bf16_t*)(ws + WS_P); const int G = C.G, bx = blockIdx.x; \
        const float* modl = mod + (size_t)l * 5 * 6144; const void* lat_res = (l == 0) ? (const void*)KA()->in[I_X] : (const void*)xb; const void* ctx_res = (l == 0) ? (const void*)KA()->in[I_CTX] : (const void*)ctxs; \
        (void)mod; (void)ctxs; (void)xb; (void)H; (void)P; (void)G; (void)bx; (void)modl; (void)lat_res; (void)ctx_res;
template <int l> __device__ __forceinline__ void layer_body(LAS unsigned char* lds) {
        const bool upd = l < DEPTH - 1;
        if (l != 2) {
        for (int rep_ = 0; rep_ < R_N1; ++rep_) { PHASE_CTX(); norm_phase<false, true, l == 0>(C, lat_res, ctx_res, KA()->in[I_NORM1] + l * DM, modl, 0, 1024, true, nullptr, (l == 0 || (l & 1)) ? ctxs : nullptr, (l & 1) ? 3 : 0); }
        GRID_BAR();
        }
        for (int rep_ = 0; rep_ < R_PROJ; ++rep_) { PHASE_CTX(); pg8::DenseOrder S{(const char*)H, (const char*)(ws + WS_WIN) + (size_t)l * 1280 * DM, (size_t)256 * DM, (size_t)256 * DM, MT, 5, G, bx, 0};
          pg8::EpiBf16<1> E{P, (const float*)(ws + WS_META + MT_SH), (const float*)(ws + WS_SCL + SCL_SWI) + l * 1280, INW, INW};
          pg8::gemm_phase<pg8::EpiBf16<1>, pg8::DenseOrder, true, true>(lds, DM / 2, DM / 2, DM / 2, S, E); }
        GRID_BAR();
        for (int rep_ = 0; rep_ < R_PROJ; ++rep_) { PHASE_CTX(); pg8::DenseOrder S{(const char*)P, (const char*)((bf16_t*)(ws + WS_WUQ) + (size_t)l * 768 * 256), (size_t)256 * INW * 2, (size_t)256 * 256 * 2, MT, 3, G, bx, 0};
          pg8::EpiBf16<0> E{(bf16_t*)(ws + WS_QRAW), nullptr, nullptr, 768, 768};
          int kk_ = 256; asm volatile("" : "+s"(kk_));
          pg8::gemm_phase<pg8::EpiBf16<0>, pg8::DenseOrder, true, true>(lds, kk_, INW, 256, S, E); }
        for (int rep_ = 0; rep_ < R_PROJ; ++rep_) { PHASE_CTX(); pg8::DenseOrder S{(const char*)(P + 256), (const char*)((bf16_t*)(ws + WS_WUKV) + (size_t)l * 1024 * 256), (size_t)256 * INW * 2, (size_t)256 * 256 * 2, MT, 4, G, (bx + G - 144) % G, 0};
          pg8::EpiBf16<0> E{(bf16_t*)(ws + WS_KVRAW), nullptr, nullptr, 1024, 1024};
          int kk_ = 256; asm volatile("" : "+s"(kk_));
          pg8::gemm_phase<pg8::EpiBf16<0>, pg8::DenseOrder, true, true>(lds, kk_, INW, 256, S, E); }
        for (int rep_ = 0; rep_ < R_F1; ++rep_) { PHASE_CTX(); fft::fft1_phase(P, (bf16_t*)(ws + WS_MID), lds, C.vcu, G); }
        if (upd) for (int rep_ = 0; rep_ < R_CF; ++rep_) { PHASE_CTX(); fft::ctxfour_phase(P, (bf16_t*)(ws + WS_FOUR), lds, C.vcu, G); }
        GRID_BAR();
        for (int rep_ = 0; rep_ < R_QK; ++rep_) { PHASE_CTX(); qkpost_phase(C, KA()->in[I_QN] + l * QKD, KA()->in[I_KN] + l * QKD, upd); }
        for (int rep_ = 0; rep_ < R_F2; ++rep_) { PHASE_CTX(); fft::fft2_phase((const bf16_t*)(ws + WS_MID), (bf16_t*)(ws + WS_FOUR), lds, C.vcu, G); }
        GRID_BAR();
        for (int rep_ = 0; rep_ < R_ATT; ++rep_) { PHASE_CTX(); const unsigned char* Q = ws + WS_Q; const unsigned char* K = ws + WS_K; const unsigned char* V = ws + WS_V; bf16_t* AT = (bf16_t*)(ws + WS_ATT);
          for (int U = C.vcu; U < 512; U += G) { const int i = U >> 8, v = U & 255, bh = v >> 3, qb = (v & 7) + 8 * i, b = bh >> 3, h = bh & 7;
              att::attn_unit(Q + ((size_t)b * SB + qb * 512) * 768 + h * 96, K + (size_t)b * SB * 768 + h * 96, V + (size_t)bh * (SB / 64) * 4096, AT + ((size_t)b * SB + qb * 512) * 512 + h * 64, SB / 64, 8, lds); }
          if (upd) for (int U = C.vcu; U < 256; U += G) { if (U & 7) continue; const int bh = U >> 3, b = bh >> 3, h = bh & 7; const size_t r0 = (size_t)b * SB + SEQ;
              att::attn_unit(Q + r0 * 768 + h * 96, K + r0 * 768 + h * 96, V + ((size_t)bh * (SB / 64) + SEQ / 64) * 4096, AT + r0 * 512 + h * 64, CTXL / 64, 4, lds); } }
        GRID_BAR();
        for (int rep_ = 0; rep_ < R_MX; ++rep_) { PHASE_CTX(); mixnorm_phase(C, KA()->in[I_ONA] + l * AW, KA()->in[I_ONF] + l * FW, upd); }
        GRID_BAR();
        { PHASE_CTX(); pg8::DenseOrder S{(const char*)H, (const char*)(ws + WS_WOUT) + (size_t)l * DM * DM, (size_t)256 * DM, (size_t)256 * DM, 128, 4, G, bx, 1};
          pg8::EpiResid<1, l == 0> E{lat_res, xb, ctx_res, ctxs, modl + 2048, (const float*)(ws + WS_META + MT_SH), (const float*)(ws + WS_SCL + SCL_SWO) + l * DM, 1.f / 127.f};
          pg8::gemm_phase<pg8::EpiResid<1, l == 0>, pg8::DenseOrder, true, true>(lds, DM / 2, DM / 2, DM / 2, S, E); }
#define CTX_WOUT(kp) { PHASE_CTX();       \
          pg8::CtxOrder S{(const char*)H + (kp) * 512, (const char*)(ws + WS_WOUT) + (size_t)l * DM * DM + (kp) * 512, (size_t)256 * DM, (size_t)256 * DM, G, (bx + G - 16 * (kp)) % G}; \
          pg8::EpiCtxPart<1> E{(float*)(ws + WS_CPART) + (size_t)(kp) * NB * CTXL * DM, modl + 2048, (const float*)(ws + WS_META + MT_SH), (const float*)(ws + WS_SCL + SCL_SWO) + l * DM, 1.f / 127.f, 0}; \
          int kk_ = 256; asm volatile("" : "+s"(kk_));     \
          pg8::gemm_phase<pg8::EpiCtxPart<1>, pg8::CtxOrder, true, true>(lds, kk_, DM / 2, DM / 2, S, E); }
        if (upd) { CTX_WOUT(0) CTX_WOUT(1) }
#undef CTX_WOUT
        GRID_BAR();
        if ((l & 1) == 0) {
            for (int rep_ = 0; rep_ < R_N2; ++rep_) { PHASE_CTX(); norm_phase<false, true, false>(C, xb, ctxs, KA()->in[I_NORM2] + l * DM, modl, 3072, 4096, upd, nullptr, upd ? ctxs : nullptr, 2); }
            GRID_BAR();
            for (int rep_ = 0; rep_ < R_GU; ++rep_) { PHASE_CTX(); pg8::DenseOrder S{(const char*)H, (const char*)(ws + WS_WGU) + (size_t)(l >> 1) * 5632 * DM, (size_t)256 * DM, (size_t)256 * DM, upd ? MT : 128, 22, G, bx, upd ? 0 : 1};
              pg8::EpiSwigluI8<true> E{(bf16_t*)(ws + WS_HID), FFN, (const float*)(ws + WS_META + MT_SH), (const float*)(ws + WS_SCL + SCL_SWD) + (l >> 1) * 5632, lds};
              pg8::gemm_phase<pg8::EpiSwigluI8<true>, pg8::DenseOrder, true, true>(lds, DM / 2, DM / 2, DM / 2, S, E); }
#ifdef R_GUX
            { PHASE_CTX(); pg8::DenseOrder S{(const char*)H, (const char*)(ws + WS_WGU) + (size_t)(l >> 1) * 5632 * DM, (size_t)256 * DM, (size_t)256 * DM, upd ? MT : 128, 22, G, bx, upd ? 0 : 1};
#if R_GUX == 0
              pg8::EpiSwigluI8<true> E{(bf16_t*)(ws + WS_Y), FFN, (const float*)(ws + WS_META + MT_SH), (const float*)(ws + WS_SCL + SCL_SWD) + (l >> 1) * 5632, lds};
              pg8::gemm_phase<pg8::EpiSwigluI8<true>, pg8::DenseOrder, true, true>(lds, DM / 2, DM / 2, DM / 2, S, E); }
#else
              pg8::EpiNullI8 E{(unsigned*)(ws + WS_Y)};
              pg8::gemm_phase<pg8::EpiNullI8, pg8::DenseOrder, true, true>(lds, DM / 2, DM / 2, DM / 2, S, E); }
#endif
#endif
            GRID_BAR();
            { PHASE_CTX(); pg8::DenseOrder S{(const char*)(ws + WS_HID), (const char*)(ws + WS_WD) + (size_t)(l >> 1) * DM * FFN, (size_t)256 * FFN, (size_t)256 * FFN, 128, 4, G, bx, 1};
              pg8::EpiResid<2, false> E{xb, xb, ctxs, ctxs, modl + 5120, nullptr, nullptr, DOWN_OSCALE};
              pg8::gemm_phase<pg8::EpiResid<2, false>, pg8::DenseOrder, true, true>(lds, FFN / 2, FFN / 2, FFN / 2, S, E); }
#define CTX_DOWN(kp) { PHASE_CTX();     \
              const int kb = (kp) * 1024, kk = ((kp) < 2) ? 512 : 384; \
              pg8::CtxOrder S{(const char*)(ws + WS_HID) + kb, (const char*)(ws + WS_WD) + (size_t)(l >> 1) * DM * FFN + kb, (size_t)256 * FFN, (size_t)256 * FFN, G, (bx + G - 16 * (kp)) % G}; \
              pg8::EpiCtxPart<2> E{(float*)(ws + WS_CPART) + (size_t)(kp) * NB * CTXL * DM, modl + 5120, nullptr, nullptr, DOWN_OSCALE, 0}; \
              pg8::gemm_phase<pg8::EpiCtxPart<2>, pg8::CtxOrder, true, true>(lds, kk, FFN / 2, FFN / 2, S, E); }
            if (upd) { CTX_DOWN(0) CTX_DOWN(1) CTX_DOWN(2) }
#undef CTX_DOWN
            GRID_BAR();
        } else {
            for (int rep_ = 0; rep_ < R_N2; ++rep_) { PHASE_CTX(); norm_phase<true, true, false>(C, xb, ctxs, KA()->in[I_NORM2] + l * DM, modl, 3072, 4096, upd, KA()->in[I_WR] + (size_t)(l >> 1) * DM * NE, upd ? ctxs : nullptr, 2); }
            GRID_BAR();
            for (int rep_ = 0; rep_ < R_ASG; ++rep_) { PHASE_CTX(); moe_assign_phase(C); }
            GRID_BAR();
            for (int rep_ = 0; rep_ < R_MOE; ++rep_) {
                { PHASE_CTX(); const int ntiles = __builtin_amdgcn_readfirstlane(*(const int*)(ws + WS_META + MT_NT)); const int* TE = (const int*)(ws + WS_META + MT_TE);
                  pg8::MoeOrder S{(const char*)(ws + WS_AMOE), (const char*)(ws + WS_MGU), (size_t)256 * DM, (size_t)256 * DM, (size_t)7168 * DM, TE, 0, ntiles, 28, G, bx, 7168};
                  pg8::EpiSwigluI8<true> E{(bf16_t*)(ws + WS_HMOE), MFF, (const float*)(ws + WS_META + MT_SA), (const float*)(ws + WS_SCL + SCL_SWM) + (size_t)(l >> 1) * 8 * 7168, lds};
                  pg8::gemm_phase<pg8::EpiSwigluI8<true>, pg8::MoeOrder, true, true>(lds, DM / 2, DM / 2, DM / 2, S, E); }
                GRID_BAR();
                { PHASE_CTX(); const int ntiles = __builtin_amdgcn_readfirstlane(*(const int*)(ws + WS_META + MT_NT)); const int* TE = (const int*)(ws + WS_META + MT_TE);
                  pg8::MoeOrder S{(const char*)(ws + WS_HMOE), (const char*)(ws + WS_MD), (size_t)256 * MFF, (size_t)256 * MFF, (size_t)DM * MFF, TE, 0, ntiles, 4, G, bx, 0};
                  pg8::EpiBf16<2> E{(bf16_t*)(ws + WS_Y), nullptr, nullptr, DM, DM};
                  pg8::gemm_phase<pg8::EpiBf16<2>, pg8::MoeOrder, true, true>(lds, MFF / 2, MFF / 2, MFF / 2, S, E); }
                GRID_BAR();
            }
            { PHASE_CTX();
              if (l == 1) { moe_combine_phase<true, false>(C, xb, ctxs, nullptr, modl, 5120, KA()->in[I_NORM1] + (l + 1) * DM, mod + (size_t)(l + 1) * 5 * 6144); conv_moe(C, 1); }
              else moe_combine_phase<false, true>(C, xb, ctxs, C.out, modl, 5120); }
            GRID_BAR();
        }
}

__global__ void __launch_bounds__(512, 2) fwd_kernel(Args args) {
    extern __shared__ __attribute__((aligned(16))) unsigned char lds_raw[];
    LAS unsigned char* lds = (LAS unsigned char*)lds_raw;
    volatile LAS unsigned* MISC = (volatile LAS unsigned*)(lds + MISC_OFF);
    if (threadIdx.x < 32) MISC[threadIdx.x] = 0u;
    __syncthreads();
    (void)xcd_barrier_post((unsigned*)(args.ws + WS_CTL), MISC + 8);

    { const int l = 0; PHASE_CTX(); ada_phase(C); conv_dense_weights(C); conv_gu(C); conv_moe(C, 0); }
    GRID_BAR();

    layer_body<0>(lds); layer_body<1>(lds); layer_body<2>(lds); layer_body<3>(lds);
}

extern "C" void kernel_launch(void* const* d_in, const int* in_sizes, int n_in, void* d_out, int out_size, void* d_ws, size_t ws_size, hipStream_t stream) {
    static int grid = 0;
    if (grid == 0) {
        if (n_in != 25 || out_size != NB * SEQ * DM || ws_size < WS_END) { fprintf(stderr, "kernel_launch: unexpected shapes (n_in %d, out %d, ws %zu < %zu)\n", n_in, out_size, ws_size, (size_t)WS_END); grid = -1; return; }
        int dev = 0, cus = 0, per_cu = 0;
        if (hipGetDevice(&dev) != hipSuccess || hipDeviceGetAttribute(&cus, hipDeviceAttributeMultiprocessorCount, dev) != hipSuccess) { grid = -1; return; }
        if (hipFuncSetAttribute((const void*)fwd_kernel, hipFuncAttributeMaxDynamicSharedMemorySize, LDS_BYTES) != hipSuccess) { fprintf(stderr, "kernel_launch: hipFuncSetAttribute failed\n"); grid = -1; return; }
        if (hipOccupancyMaxActiveBlocksPerMultiprocessor(&per_cu, (const void*)fwd_kernel, 512, LDS_BYTES) != hipSuccess || per_cu < 1) { fprintf(stderr, "kernel_launch: occupancy query says %d\n", per_cu); }
        (void)hipGetLastError();
        grid = (cus >= 256) ? 256 : -1;
        if (grid < 0) fprintf(stderr, "kernel_launch: needs a 256-CU device (got %d)\n", cus);
    }
    if (grid < 0) return;
    if (hipMemsetAsync((char*)d_ws + WS_CTL, 0, CTL_ZERO_BYTES, stream) != hipSuccess) return;
    Args a{};
    for (int i = 0; i < 25; ++i) a.in[i] = (const float*)d_in[i];
    a.out = (float*)d_out; a.ws = (unsigned char*)d_ws; a.pad0 = 0; a.pad1 = 0;
    hipLaunchKernelGGL(fwd_kernel, dim3(grid), dim3(512), LDS_BYTES, stream, a);
}
```

```cpp
#include <hip/hip_runtime.h>
#include <cstdio>
#include <cstdint>

#define GAS __attribute__((address_space(1)))
#define LAS __attribute__((address_space(3)))
typedef unsigned short bf16_t;
typedef short bf16x8 __attribute__((ext_vector_type(8)));
typedef short s16x4 __attribute__((ext_vector_type(4)));
typedef float f32x2 __attribute__((ext_vector_type(2)));
typedef float f32x4 __attribute__((ext_vector_type(4)));
typedef float f32x16 __attribute__((ext_vector_type(16)));
typedef unsigned u32x2 __attribute__((ext_vector_type(2)));
typedef unsigned u32x4 __attribute__((ext_vector_type(4)));

constexpr int NB = 4, SEQ = 8192, CTXL = 256, SB = SEQ + CTXL, TT = NB * SB;
constexpr int DM = 1024, INW = 1056, NH = 8, QKD = 96, VD = 64, AW = 512, FW = 512;
constexpr int FFN = 2816, NE = 8, MFF = 3584, DEPTH = 4;
constexpr int MT = TT / 256;
constexpr float EPS = 1e-6f;
constexpr float QSCALE = 0.10206207261596577f * 1.4426950408889634f;

constexpr size_t MiB = 1u << 20;
constexpr size_t WS_CTL = 0, CTL_ZERO_BYTES = 16384;
constexpr size_t WS_MOD = 1 * MiB;
constexpr size_t WS_META = 2 * MiB;
constexpr size_t WS_CTXS = 4 * MiB;
constexpr size_t WS_SCL = 8 * MiB, SCL_ZERO_BYTES = 576 * 1024;
constexpr size_t SCL_SWM = 0, SCL_SWD = 2 * 8 * 7168 * 4, SCL_SWO = SCL_SWD + 2 * 5632 * 4, SCL_SWI = SCL_SWO + 4 * 1024 * 4;
constexpr size_t SCL_END = SCL_SWI + 4 * 1280 * 4;
static_assert(SCL_END <= SCL_ZERO_BYTES, "scale map");
constexpr size_t WS_WIN = 16 * MiB;
constexpr size_t WS_WUQ = 26 * MiB;
constexpr size_t WS_WUKV = 28 * MiB;
constexpr size_t WS_WOUT = 30 * MiB;
constexpr size_t WS_WGU = 38 * MiB;
constexpr size_t WS_WD = 60 * MiB;
constexpr size_t WS_MGU = 72 * MiB;
constexpr size_t WS_MD = 184 * MiB;
constexpr size_t WS_H = 240 * MiB;
constexpr size_t WS_R = 306 * MiB;
constexpr size_t WS_P = WS_R;
constexpr size_t WS_QRAW = WS_R + 69 * MiB;
constexpr size_t WS_KVRAW = WS_R + 119 * MiB;
constexpr size_t WS_Q = WS_R + 185 * MiB;
constexpr size_t WS_K = WS_R + 235 * MiB;
constexpr size_t WS_V = WS_R + 285 * MiB;
constexpr size_t WS_ATT = WS_R + 318 * MiB;
constexpr size_t WS_FOUR = WS_R + 351 * MiB;
constexpr size_t WS_MID = WS_R + 384 * MiB;
constexpr size_t WS_HID = WS_R;
constexpr size_t WS_AMOE = WS_R;
constexpr size_t WS_HMOE = WS_R + 68 * MiB;
constexpr size_t WS_Y = WS_R + 306 * MiB;
constexpr size_t WS_CPART = WS_R + 448 * MiB;
constexpr size_t WS_XB = WS_R + 496 * MiB;
constexpr size_t WS_XCB = WS_XB + 64 * MiB;
constexpr size_t WS_END = WS_XCB + 2 * MiB;
static_assert((size_t)TT * INW * 2 <= 69 * MiB && (size_t)TT * 768 * 2 <= 50 * MiB && (size_t)TT * 1024 * 2 <= 66 * MiB && (size_t)TT * 512 * 2 <= 33 * MiB, "activation sizes");
static_assert(WS_MID + 64 * MiB <= WS_END && (size_t)TT * FFN * 2 <= 182 * MiB, "map");
constexpr size_t MT_RE = 0, MT_RW = 270336 * 1, MT_LR = 270336 * 2, MT_TS = 270336 * 3, MT_BC = 270336 * 4, MT_TE = MT_BC + 8192, MT_NT = MT_TE + 2048;
constexpr size_t MT_SA = 1310720, MT_SWM = 1605632, MT_SH = 1835008, MT_SWD = 1970176;
static_assert(MT_NT + 64 <= MT_SA && MT_SA + 69632 * 4 <= MT_SWM && MT_SWM + 8 * 7168 * 4 <= MT_SH && MT_SH + TT * 4 <= MT_SWD && MT_SWD + 2 * 5632 * 4 <= 2 * MiB, "meta map");
constexpr int MOE_ROWS_MAX = 69632, MOE_MAX_TILES = 272;
static_assert(WS_HMOE + (size_t)MOE_ROWS_MAX * MFF <= WS_Y && WS_Y + (size_t)MOE_ROWS_MAX * DM * 2 <= WS_END, "moe map");
constexpr float HID_SCALE = 8.f, WD_SCALE = 64.f, DOWN_OSCALE = 1.f / 512.f;

constexpr int RING_BYTES = 131072, MISC_OFF = RING_BYTES, LDS_BYTES = 147456;

__device__ __forceinline__ unsigned cvt_pk_bf16(float lo, float hi) { unsigned r; asm volatile("v_cvt_pk_bf16_f32 %0, %1, %2" : "=v"(r) : "v"(lo), "v"(hi)); return r; }
__device__ __forceinline__ float bflo(unsigned u) { return __uint_as_float(u << 16); }
__device__ __forceinline__ float bfhi(unsigned u) { return __uint_as_float(u & 0xffff0000u); }
__device__ __forceinline__ float wave_sum(float v) {
#pragma unroll
    for (int o = 1; o < 64; o <<= 1) v += __shfl_xor(v, o);
    return v;
}
#define LDS_WAIT() asm volatile("s_waitcnt lgkmcnt(0)" ::: "memory")
#define VM_WAIT() asm volatile("s_waitcnt vmcnt(0)" ::: "memory")
__device__ __forceinline__ int otid() { int t = threadIdx.x; asm volatile("" : "+v"(t)); return t; }
namespace pg8 {
#define PG8_LAS __attribute__((address_space(3)))
#ifndef T_WGM
#define T_WGM 8
#endif
#ifndef T_XCD
#define T_XCD 1
#endif
constexpr int BM = 256, BK = 64, HALF = 128, HTB = HALF * BK * 2  , STAGE_BYTES = 8 * HTB, NXCD = 8, WGM = T_WGM;
__host__ __device__ __forceinline__ int lds_byte(int r, int c) { const int st = (r >> 4) * 2 + (c >> 5), rr = r & 15, cc = c & 31, ob = rr * 64 + cc * 2; return st * 1024 + (ob ^ (((ob >> 9) & 1) << 5)); }
__host__ __device__ __forceinline__ void stage_rc(int b, int& R, int& C) { const int st = b / 1024, sb = b % 1024, swz = sb ^ (((sb >> 9) & 1) << 5); R = (st >> 1) * 16 + swz / 64; C = (st & 1) * 32 + (swz % 64) / 2; }
__host__ __device__ __forceinline__ int perm32(int rho) { const int n = rho >> 4, i = rho & 15; return 8 * (i >> 2) + 4 * n + (i & 3); }

typedef int i32x4 __attribute__((ext_vector_type(4)));
typedef int i32x8 __attribute__((ext_vector_type(8)));
template <int MODE> struct AccOf { typedef f32x4 T; };
template <> struct AccOf<1> { typedef i32x4 T; };
template <int MODE> __device__ __forceinline__ typename AccOf<MODE>::T mma16(bf16x8 a, bf16x8 b, typename AccOf<MODE>::T c) {
    if constexpr (MODE == 1) return __builtin_amdgcn_mfma_i32_16x16x64_i8(__builtin_bit_cast(i32x4, a), __builtin_bit_cast(i32x4, b), c, 0, 0, 0);
    else return __builtin_amdgcn_mfma_f32_16x16x32_bf16(a, b, c, 0, 0, 0);
}
__device__ __forceinline__ f32x4 mma_f8(bf16x8 a0, bf16x8 a1, bf16x8 b0, bf16x8 b1, f32x4 c) {
    const i32x4 x0 = __builtin_bit_cast(i32x4, a0), x1 = __builtin_bit_cast(i32x4, a1), y0 = __builtin_bit_cast(i32x4, b0), y1 = __builtin_bit_cast(i32x4, b1);
    const i32x8 A = {x0[0], x0[1], x0[2], x0[3], x1[0], x1[1], x1[2], x1[3]}, B = {y0[0], y0[1], y0[2], y0[3], y1[0], y1[1], y1[2], y1[3]};
    return __builtin_amdgcn_mfma_scale_f32_16x16x128_f8f6f4(A, B, c, 0, 0, 0, 0x7F7F7F7F, 0, 0x7F7F7F7F);
}
__device__ __forceinline__ i32x8 cat8(bf16x8 lo, bf16x8 hi) { const i32x4 a = __builtin_bit_cast(i32x4, lo), b = __builtin_bit_cast(i32x4, hi); return __builtin_shufflevector(a, b, 0, 1, 2, 3, 4, 5, 6, 7); }
struct Unit { const char* A; const char* B; int pm, pn, B_scale_off, par; };

__device__ __forceinline__ bool tile_order(int i, int G, int c, int nM, int nN, int& tm, int& tn) {
    const int nwg = nM * nN; const long L = (long)i * G + c; if (L >= nwg) return false;
    int wgid = (int)L; if (T_XCD) { const int q = nwg / NXCD, r = nwg % NXCD, xcd = wgid % NXCD, off = wgid / NXCD; wgid = (xcd < r ? xcd * (q + 1) : r * (q + 1) + (xcd - r) * q) + off; }
    const int nig = WGM * nN, gid = wgid / nig, fm = gid * WGM, gsz = (nM - fm) < WGM ? (nM - fm) : WGM;
    tm = fm + ((wgid % nig) % gsz); tn = (wgid % nig) / gsz; return true;
}
struct DenseOrder {
    const char* A; const char* B; size_t a_tile_bytes, b_tile_bytes; int nM, nN, G, c, skipctx;
    __device__ __forceinline__ bool next(int i, Unit& u) const {
        int tm, tn; if (!tile_order(i, G, c, nM, nN, tm, tn)) return false;
        const int pm = skipctx ? tm + (tm >> 5) : tm; u.pm = pm; u.pn = tn; u.B_scale_off = 0; u.A = A + (size_t)pm * a_tile_bytes; u.B = B + (size_t)tn * b_tile_bytes; return true;
    }
};
struct CtxOrder {
    const char* A; const char* B; size_t a_tile_bytes, b_tile_bytes; int G, c;
    __device__ __forceinline__ bool next(int i, Unit& u) const {
        const int L = i * G + c; if (L >= 16) return false;
        const int pm = (L >> 2) * 33 + 32; u.pm = pm; u.pn = L & 3; u.B_scale_off = 0; u.A = A + (size_t)pm * a_tile_bytes; u.B = B + (size_t)(L & 3) * b_tile_bytes; return true;
    }
};
struct MoeOrder {
    const char* A; const char* B; size_t a_tile_bytes, b_tile_bytes, b_exp_bytes; const PG8_LAS int* tile_exp; int tile0, nM, nN, G, c, b_exp_rows;
    __device__ __forceinline__ bool next(int i, Unit& u) const {
        int tm, tn; if (!tile_order(i, G, c, nM, nN, tm, tn)) return false;
        const int e = __builtin_amdgcn_readfirstlane(tile_exp[tile0 + tm]);
        u.pm = tm; u.pn = tn; u.B_scale_off = e * b_exp_rows; u.A = A + (size_t)tm * a_tile_bytes; u.B = B + (size_t)e * b_exp_bytes + (size_t)tn * b_tile_bytes; return true;
    }
};

template <int MODE_> struct EpiBf16 {
    static constexpr bool PERM = true, AFTER_DRAIN = false, PREFETCH = false; static constexpr int MODE = MODE_;
    bf16_t* O; const float* sa; const float* sw; int ldc, ncols;
    __device__ __forceinline__ void operator()(const typename AccOf<MODE_>::T (&acc)[2][2][4][2], const Unit& u, int wr, int wc, int fr, int fq) const {
        const int row0 = u.pm * BM + wr * 64 + fr, col0 = u.pn * BM + wc * 32 + 8 * fq;
        f32x4 ws_[2][2];
        if constexpr (MODE_ == 1) {
#pragma unroll
            for (int bj = 0; bj < 2; ++bj) { ws_[bj][0] = *(const f32x4*)(sw + col0 + bj * HALF) * (1.f / 127.f); ws_[bj][1] = *(const f32x4*)(sw + col0 + bj * HALF + 4) * (1.f / 127.f); } }
#pragma unroll
        for (int ai = 0; ai < 2; ++ai)
#pragma unroll
            for (int m = 0; m < 4; ++m) { bf16_t* rowp = O + (size_t)(row0 + ai * HALF + m * 16) * ldc + col0; float rs = 1.f; if constexpr (MODE_ == 1) rs = sa[row0 + ai * HALF + m * 16];
#pragma unroll
                for (int bj = 0; bj < 2; ++bj) { if (col0 + bj * HALF < ncols) { f32x4 v0, v1; if constexpr (MODE_ == 1) { v0 = __builtin_convertvector(acc[ai][bj][m][0], f32x4) * (ws_[bj][0] * rs); v1 = __builtin_convertvector(acc[ai][bj][m][1], f32x4) * (ws_[bj][1] * rs); } else { v0 = acc[ai][bj][m][0]; v1 = acc[ai][bj][m][1]; }
                    u32x4 w; w.x = cvt_pk_bf16(v0[0], v0[1]); w.y = cvt_pk_bf16(v0[2], v0[3]); w.z = cvt_pk_bf16(v1[0], v1[1]); w.w = cvt_pk_bf16(v1[2], v1[3]);
                    *(u32x4*)(rowp + bj * HALF) = w; } } }
    }
};
__device__ __forceinline__ float silu_mul(float g, float u) { return g * u * __builtin_amdgcn_rcpf(1.f + __builtin_amdgcn_exp2f(-1.4426950408889634f * g)); }
template <int MODE_, bool SRC_F32> struct EpiResid {
    static constexpr bool PERM = false, AFTER_DRAIN = false, PREFETCH = false; static constexpr int MODE = MODE_;
    const void* lat_in; bf16_t* lat_out; const void* ctx_in; bf16_t* ctx_out; const float* gate; const float* sa; const float* sw; float oscale;
    __device__ __forceinline__ void operator()(const typename AccOf<MODE_>::T (&acc)[2][2][4][2], const Unit& u, int wr, int wc, int fr, int fq) const {
        const int b = u.pm / 33, j = u.pm % 33; const unsigned char* src; bf16_t* dst; int mr;
        if (j < 32) { const size_t off = ((size_t)b * SEQ + (size_t)j * 256) * DM; src = (const unsigned char*)lat_in + off * (SRC_F32 ? 4 : 2); dst = lat_out + off; mr = b; }
        else { const size_t off = (size_t)b * CTXL * DM; src = (const unsigned char*)ctx_in + off * (SRC_F32 ? 4 : 2); dst = ctx_out + off; mr = 4; }
        const int col0 = u.pn * BM + wc * 32 + 4 * fq; const float* gp = gate + (size_t)mr * 6144 + col0;
        f32x4 gv[2][2];
#pragma unroll
        for (int bj = 0; bj < 2; ++bj)
#pragma unroll
            for (int n = 0; n < 2; ++n) { gv[bj][n] = *(const f32x4*)(gp + bj * HALF + n * 16) * oscale; if constexpr (MODE_ == 1) gv[bj][n] = gv[bj][n] * *(const f32x4*)(sw + col0 + bj * HALF + n * 16); }
#pragma unroll
        for (int ai = 0; ai < 2; ++ai)
#pragma unroll
            for (int m = 0; m < 4; ++m) { const int rl = wr * 64 + fr + ai * HALF + m * 16; const size_t ro = (size_t)rl * DM + col0;
                float rs = 1.f; if constexpr (MODE_ == 1) rs = sa[u.pm * BM + rl];
#pragma unroll
                for (int bj = 0; bj < 2; ++bj)
#pragma unroll
                    for (int n = 0; n < 2; ++n) { const size_t e = ro + bj * HALF + n * 16; f32x4 x;
                        if constexpr (SRC_F32) x = *(const f32x4*)(src + e * 4); else { const u32x2 xb = *(const u32x2*)(src + e * 2); x = (f32x4){__uint_as_float(xb.x << 16), __uint_as_float(xb.x & 0xffff0000u), __uint_as_float(xb.y << 16), __uint_as_float(xb.y & 0xffff0000u)}; }
                        if constexpr (MODE_ == 1) x = x + (gv[bj][n] * rs) * __builtin_convertvector(acc[ai][bj][m][n], f32x4); else x = x + gv[bj][n] * acc[ai][bj][m][n];
                        *(u32x2*)(dst + e) = (u32x2){cvt_pk_bf16(x[0], x[1]), cvt_pk_bf16(x[2], x[3])}; } }
    }
};


__device__ __forceinline__ float clamp448(float x) { return fminf(fmaxf(x, -448.f), 448.f); }
template <bool F8OUT> struct EpiSwigluI8 {
    static constexpr bool PERM = true, AFTER_DRAIN = false, PREFETCH = true; static constexpr int MODE = 1;
    bf16_t* O; int ldc; const float* sa; const float* sw; PG8_LAS unsigned char* l;
    __device__ __forceinline__ void prefetch(const Unit& u, int wid, int lane) const {
        const float* src = (wid < 4) ? sa + (size_t)u.pm * BM + wid * 64 : sw + u.B_scale_off + u.pn * BM + (wid - 4) * 64;
        __builtin_amdgcn_global_load_lds((const unsigned*)(src + lane), (PG8_LAS unsigned*)(l + MISC_OFF + 4096 + u.par * 2048 + wid * 256), 4, 0, 0); }
    __device__ __forceinline__ void operator()(const i32x4 (&acc)[2][2][4][2], const Unit& u, int wr, int wc, int fr, int fq) const {
        const int row0 = u.pm * BM + wr * 64 + fr, col0 = u.pn * HALF + wc * 32 + 8 * fq;
        const PG8_LAS float* ls = (const PG8_LAS float*)(l + MISC_OFF + 4096 + u.par * 2048); const PG8_LAS float* swp = ls + 256 + wc * 32 + 8 * fq;
        const f32x4 wg0 = *(const PG8_LAS f32x4*)swp, wg1 = *(const PG8_LAS f32x4*)(swp + 4), wu0 = *(const PG8_LAS f32x4*)(swp + HALF), wu1 = *(const PG8_LAS f32x4*)(swp + HALF + 4);
#pragma unroll
        for (int ai = 0; ai < 2; ++ai)
#pragma unroll
            for (int m = 0; m < 4; ++m) { const int row = row0 + ai * HALF + m * 16; bf16_t* rowp = O + (size_t)row * ldc + col0; const float s = ls[wr * 64 + fr + ai * HALF + m * 16] * (1.f / 127.f);
                const i32x4 g0i = acc[ai][0][m][0], g1i = acc[ai][0][m][1], u0i = acc[ai][1][m][0], u1i = acc[ai][1][m][1];
                if constexpr (F8OUT) {
                    const f32x4 G0 = __builtin_convertvector(g0i, f32x4) * wg0, G1 = __builtin_convertvector(g1i, f32x4) * wg1, U0 = __builtin_convertvector(u0i, f32x4) * wu0, U1 = __builtin_convertvector(u1i, f32x4) * wu1;
                    const float c1 = -1.4426950408889634f * s, c2 = HID_SCALE * s * s;
#define SW8(G_, U_, i_) clamp448((G_[i_] * U_[i_]) * (c2 * __builtin_amdgcn_rcpf(1.f + __builtin_amdgcn_exp2f(G_[i_] * c1))))
                    int w0 = 0, w1 = 0;
                    w0 = __builtin_amdgcn_cvt_pk_fp8_f32(SW8(G0, U0, 0), SW8(G0, U0, 1), w0, false); w0 = __builtin_amdgcn_cvt_pk_fp8_f32(SW8(G0, U0, 2), SW8(G0, U0, 3), w0, true);
                    w1 = __builtin_amdgcn_cvt_pk_fp8_f32(SW8(G1, U1, 0), SW8(G1, U1, 1), w1, false); w1 = __builtin_amdgcn_cvt_pk_fp8_f32(SW8(G1, U1, 2), SW8(G1, U1, 3), w1, true);
#undef SW8
                    *(u32x2*)((unsigned char*)O + (size_t)row * ldc + col0) = (u32x2){(unsigned)w0, (unsigned)w1}; }
                else { const f32x4 g0 = __builtin_convertvector(g0i, f32x4) * (wg0 * s), g1 = __builtin_convertvector(g1i, f32x4) * (wg1 * s), u0 = __builtin_convertvector(u0i, f32x4) * (wu0 * s), u1 = __builtin_convertvector(u1i, f32x4) * (wu1 * s);
                    u32x4 w; w.x = cvt_pk_bf16(silu_mul(g0[0], u0[0]), silu_mul(g0[1], u0[1])); w.y = cvt_pk_bf16(silu_mul(g0[2], u0[2]), silu_mul(g0[3], u0[3]));
                    w.z = cvt_pk_bf16(silu_mul(g1[0], u1[0]), silu_mul(g1[1], u1[1])); w.w = cvt_pk_bf16(silu_mul(g1[2], u1[2]), silu_mul(g1[3], u1[3]));
                    *(u32x4*)rowp = w; } }
    }
};

struct EpiNullI8 {
    static constexpr bool PERM = true, AFTER_DRAIN = false, PREFETCH = false; static constexpr int MODE = 1;
    unsigned* O;
    __device__ __forceinline__ void operator()(const i32x4 (&acc)[2][2][4][2], const Unit& u, int wr, int wc, int fr, int fq) const {
        i32x4 s = acc[0][0][0][0];
#pragma unroll
        for (int ai = 0; ai < 2; ++ai)
#pragma unroll
            for (int bj = 0; bj < 2; ++bj)
#pragma unroll
                for (int m = 0; m < 4; ++m)
#pragma unroll
                    for (int n = 0; n < 2; ++n) s ^= acc[ai][bj][m][n];
        *(i32x4*)(O + ((size_t)(u.pm * 32 + u.pn) * 512 + threadIdx.x) * 4) = s;
    }
};

template <int MODE_> struct EpiCtxPart {
    static constexpr bool PERM = false, AFTER_DRAIN = false, PREFETCH = false; static constexpr int MODE = MODE_;
    float* part; const float* gate; const float* sa; const float* sw; float oscale; int pad_;
    __device__ __forceinline__ void operator()(const typename AccOf<MODE_>::T (&acc)[2][2][4][2], const Unit& u, int wr, int wc, int fr, int fq) const {
        const int b = u.pm / 33; float* dst = part + (size_t)b * CTXL * DM;
        const int col0 = u.pn * BM + wc * 32 + 4 * fq; const float* gp = gate + (size_t)4 * 6144 + col0;
        f32x4 gv[2][2];
#pragma unroll
        for (int bj = 0; bj < 2; ++bj)
#pragma unroll
            for (int n = 0; n < 2; ++n) { gv[bj][n] = *(const f32x4*)(gp + bj * HALF + n * 16) * oscale; if constexpr (MODE_ == 1) gv[bj][n] = gv[bj][n] * *(const f32x4*)(sw + col0 + bj * HALF + n * 16); }
#pragma unroll
        for (int ai = 0; ai < 2; ++ai)
#pragma unroll
            for (int m = 0; m < 4; ++m) { const int rl = wr * 64 + fr + ai * HALF + m * 16; const size_t ro = (size_t)rl * DM + col0; float rs = 1.f; if constexpr (MODE_ == 1) rs = sa[u.pm * BM + rl];
#pragma unroll
                for (int bj = 0; bj < 2; ++bj)
#pragma unroll
                    for (int n = 0; n < 2; ++n) { if constexpr (MODE_ == 1) *(f32x4*)(dst + ro + bj * HALF + n * 16) = (gv[bj][n] * rs) * __builtin_convertvector(acc[ai][bj][m][n], f32x4); else *(f32x4*)(dst + ro + bj * HALF + n * 16) = gv[bj][n] * acc[ai][bj][m][n]; } }
    }
};
template <class Epi, class Sched, bool ALIGN_EPI = false, bool SP2 = false>
__device__ __forceinline__ void gemm_phase(PG8_LAS unsigned char* lds, const int K, const int lda, const int ldb, const Sched S, const Epi E) {
    const int tid = otid(), wid = __builtin_amdgcn_readfirstlane(tid >> 6), lane = tid & 63, wr = wid >> 2, wc = wid & 3, fr = lane & 15, fq = lane >> 4;
    const int nt = K / BK;
    unsigned voffA[2], voffB[2];
#pragma unroll
    for (int i = 0; i < 2; ++i) { int R, C; stage_rc(tid * 16 + i * 8192, R, C); const int Rb = Epi::PERM ? ((R & ~31) + perm32(R & 31)) : R;
        voffA[i] = (unsigned)(R * lda + C) * 2u; voffB[i] = (unsigned)(Rb * ldb + C) * 2u; }
    const size_t kstep = (size_t)(BK * 2);
    const size_t hstepA = (size_t)HALF * lda * 2, hstepB = (size_t)HALF * ldb * 2;
    const unsigned ldsw = (unsigned)wid * 1024u;
    const int aoff = lds_byte(wr * 64 + fr, fq * 8), boff = lds_byte(wc * 32 + fr, fq * 8);
#define PG8_SA(b, h) (((b) * 2 + (h)) * HTB)
#define PG8_SB(b, h) ((4 + (b) * 2 + (h)) * HTB)
#define PG8_STAGE(bufoff, gbase, voff) do { _Pragma("unroll") for (int _i = 0; _i < 2; ++_i) \
        __builtin_amdgcn_global_load_lds((const unsigned*)((const char*)(gbase) + (voff)[_i]), (PG8_LAS unsigned*)(lds + (bufoff) + ldsw + _i * 8192), 16, 0, 0); } while (0)
#define PG8_LDA(dst, b, h) do { _Pragma("unroll") for (int m = 0; m < 4; ++m) { const bf16x8 lo_ = *(const PG8_LAS bf16x8*)(lds + PG8_SA(b, h) + aoff + m * 2048), hi_ = *(const PG8_LAS bf16x8*)(lds + PG8_SA(b, h) + aoff + m * 2048 + 1024); \
        if constexpr (Epi::MODE == 2) dst##8[m] = cat8(lo_, hi_); else { dst[m][0] = lo_; dst[m][1] = hi_; } } } while (0)
#define PG8_LDB(dst, b, h) do { _Pragma("unroll") for (int n = 0; n < 2; ++n) { const bf16x8 lo_ = *(const PG8_LAS bf16x8*)(lds + PG8_SB(b, h) + boff + n * 2048), hi_ = *(const PG8_LAS bf16x8*)(lds + PG8_SB(b, h) + boff + n * 2048 + 1024); \
        if constexpr (Epi::MODE == 2) dst##8[n] = cat8(lo_, hi_); else { dst[n][0] = lo_; dst[n][1] = hi_; } } } while (0)
#define PG8_MMA(ai, bj, At, Bt) do { __builtin_amdgcn_s_setprio(1); _Pragma("unroll") for (int m = 0; m < 4; ++m) _Pragma("unroll") for (int n = 0; n < 2; ++n) { \
        if constexpr (Epi::MODE == 2) asm volatile("v_mfma_f32_16x16x128_f8f6f4 %0, %1, %2, %0" : "+v"(acc[ai][bj][m][n]) : "v"(Bt##8[n]), "v"(At##8[m]));   \
        else { _Pragma("unroll") for (int k = 0; k < 2; ++k) acc[ai][bj][m][n] = mma16<Epi::MODE>(Bt[n][k], At[m][k], acc[ai][bj][m][n]); } } __builtin_amdgcn_s_setprio(0); } while (0)
#define PG8_WAIT_V(n) asm volatile("s_waitcnt vmcnt(" #n ")" ::: "memory")
#define PG8_WAIT_L(n) asm volatile("s_waitcnt lgkmcnt(" #n ")" ::: "memory")
#define PG8_BAR __builtin_amdgcn_s_barrier()
#define PG8_SCHED __builtin_amdgcn_sched_barrier(0)
    Unit cur, nxt; int ui = 0;
    if (!S.next(0, cur)) return;
    typedef typename AccOf<Epi::MODE>::T AccT;
    AccT acc[2][2][4][2];
#pragma unroll
    for (int a = 0; a < 2; ++a)
#pragma unroll
        for (int b = 0; b < 2; ++b)
#pragma unroll
            for (int m = 0; m < 4; ++m)
#pragma unroll
                for (int n = 0; n < 2; ++n) acc[a][b][m][n] = AccT{};
    bf16x8 At[4][2], B0[2][2], B1[2][2]; i32x8 At8[4], B08[2], B18[2];
    const char* cA = cur.A; const char* cB = cur.B;
    if constexpr (SP2) {
        PG8_STAGE(PG8_SB(0, 0), cB, voffB); PG8_STAGE(PG8_SB(0, 1), cB + hstepB, voffB); PG8_STAGE(PG8_SA(0, 0), cA, voffA); PG8_STAGE(PG8_SA(0, 1), cA + hstepA, voffA);
        if (wr == 1) PG8_BAR;
        PG8_WAIT_V(2); PG8_BAR;
        PG8_STAGE(PG8_SB(1, 0), cB + kstep, voffB); PG8_STAGE(PG8_SA(1, 0), cA + kstep, voffA); PG8_STAGE(PG8_SB(1, 1), cB + hstepB + kstep, voffB);
        PG8_WAIT_V(6); PG8_BAR;
    } else {
        PG8_STAGE(PG8_SB(0, 0), cB, voffB); PG8_STAGE(PG8_SA(0, 0), cA, voffA); PG8_STAGE(PG8_SB(0, 1), cB + hstepB, voffB); PG8_STAGE(PG8_SA(0, 1), cA + hstepA, voffA);
        if (wr == 1) PG8_BAR;
        PG8_WAIT_V(4); PG8_BAR;
        PG8_STAGE(PG8_SB(1, 0), cB + kstep, voffB); PG8_STAGE(PG8_SA(1, 0), cA + kstep, voffA); PG8_STAGE(PG8_SB(1, 1), cB + hstepB + kstep, voffB);
        PG8_WAIT_V(6); PG8_BAR;
    }
    for (;;) {
        cur.par = ui & 1; if constexpr (Epi::PREFETCH) E.prefetch(cur, wid, lane);
        const bool has_next = S.next(ui + 1, nxt);
        const char* nA = has_next ? nxt.A : cA; const char* nB = has_next ? nxt.B : cB;
        for (int t = 0; t < nt; t += 2) {
            const bool last = (t == nt - 2);
            const char* a1 = cA + (size_t)(t + 1) * kstep;
            const char* a2 = last ? nA : cA + (size_t)(t + 2) * kstep; const char* b2 = last ? nB : cB + (size_t)(t + 2) * kstep;
            const char* a3 = a2 + kstep; const char* b3 = b2 + kstep;
            if constexpr (SP2) {
            PG8_LDB(B0, 0, 0); PG8_LDB(B1, 0, 1); PG8_SCHED; PG8_LDA(At, 0, 0); PG8_STAGE(PG8_SA(1, 1), a1 + hstepA, voffA);
            PG8_WAIT_V(8); PG8_WAIT_L(0); PG8_BAR; PG8_MMA(0, 0, At, B0); PG8_MMA(0, 1, At, B1); PG8_BAR; PG8_SCHED;
            PG8_LDA(At, 0, 1); PG8_STAGE(PG8_SB(0, 0), b2, voffB); PG8_STAGE(PG8_SB(0, 1), b2 + hstepB, voffB); PG8_STAGE(PG8_SA(0, 0), a2, voffA);
            PG8_WAIT_V(8); PG8_WAIT_L(0); PG8_BAR; PG8_MMA(1, 0, At, B0); PG8_MMA(1, 1, At, B1); PG8_BAR; PG8_SCHED;
            PG8_LDB(B0, 1, 0); PG8_LDB(B1, 1, 1); PG8_SCHED; PG8_LDA(At, 1, 0); PG8_STAGE(PG8_SA(0, 1), a2 + hstepA, voffA);
            PG8_WAIT_V(8); PG8_WAIT_L(0); PG8_BAR; PG8_MMA(0, 0, At, B0); PG8_MMA(0, 1, At, B1); PG8_BAR; PG8_SCHED;
            PG8_LDA(At, 1, 1); PG8_STAGE(PG8_SB(1, 0), b3, voffB); PG8_STAGE(PG8_SB(1, 1), b3 + hstepB, voffB); PG8_STAGE(PG8_SA(1, 0), a3, voffA);
            PG8_WAIT_V(8); PG8_WAIT_L(0); PG8_BAR; PG8_MMA(1, 0, At, B0); PG8_MMA(1, 1, At, B1); PG8_BAR; PG8_SCHED;
            } else {
            PG8_LDB(B0, 0, 0); PG8_SCHED; PG8_LDA(At, 0, 0); PG8_STAGE(PG8_SA(1, 1), a1 + hstepA, voffA);
            PG8_WAIT_L(8); PG8_BAR; PG8_WAIT_L(0); PG8_MMA(0, 0, At, B0); PG8_BAR; PG8_SCHED;
            PG8_LDB(B1, 0, 1); PG8_STAGE(PG8_SB(0, 0), b2, voffB);
            PG8_BAR; PG8_WAIT_L(0); PG8_MMA(0, 1, At, B1); PG8_BAR;
            PG8_LDA(At, 0, 1); PG8_STAGE(PG8_SA(0, 0), a2, voffA);
            PG8_BAR; PG8_WAIT_L(0); PG8_MMA(1, 0, At, B0); PG8_BAR; PG8_SCHED;
            PG8_STAGE(PG8_SB(0, 1), b2 + hstepB, voffB);
            PG8_WAIT_V(6); PG8_BAR; PG8_MMA(1, 1, At, B1); PG8_BAR;
            PG8_LDB(B0, 1, 0); PG8_SCHED; PG8_LDA(At, 1, 0); PG8_STAGE(PG8_SA(0, 1), a2 + hstepA, voffA);
            PG8_WAIT_L(8); PG8_BAR; PG8_WAIT_L(0); PG8_MMA(0, 0, At, B0); PG8_BAR; PG8_SCHED;
            PG8_LDB(B1, 1, 1); PG8_STAGE(PG8_SB(1, 0), b3, voffB);
            PG8_BAR; PG8_WAIT_L(0); PG8_MMA(0, 1, At, B1); PG8_BAR;
            PG8_LDA(At, 1, 1); PG8_STAGE(PG8_SA(1, 0), a3, voffA);
            PG8_BAR; PG8_WAIT_L(0); PG8_MMA(1, 0, At, B0); PG8_BAR; PG8_SCHED;
            PG8_STAGE(PG8_SB(1, 1), b3 + hstepB, voffB);
            PG8_WAIT_V(6); PG8_BAR; PG8_MMA(1, 1, At, B1); PG8_BAR;
            }
        }
        if constexpr (ALIGN_EPI) { if (wr == 0) PG8_BAR; }
        if constexpr (Epi::MODE == 2) asm volatile("s_nop 15\n\ts_nop 15" ::: "memory");
        if constexpr (!Epi::AFTER_DRAIN) { E(acc, cur, wr, wc, fr, fq); }
        if (!has_next) break;
#pragma unroll
        for (int a = 0; a < 2; ++a)
#pragma unroll
            for (int b = 0; b < 2; ++b)
#pragma unroll
                for (int m = 0; m < 4; ++m)
#pragma unroll
                    for (int n = 0; n < 2; ++n) acc[a][b][m][n] = AccT{};
        cur = nxt; cA = nA; cB = nB; ++ui;
        if constexpr (ALIGN_EPI) { if (wr == 1) PG8_BAR; }
    }
    PG8_WAIT_V(0);
    if constexpr (!ALIGN_EPI) { if (wr == 0) PG8_BAR; }
    PG8_BAR;
#undef PG8_SA
#undef PG8_SB
#undef PG8_STAGE
#undef PG8_LDA
#undef PG8_LDB
#undef PG8_MMA
#undef PG8_WAIT_V
#undef PG8_WAIT_L
#undef PG8_BAR
#undef PG8_SCHED
}
}
#define XB_TMO      128
#define XB_XCNT(j)  (256  + 64 * (j))
#define XB_XSUB(j)  (1280 + 64 * (j))
#define XB_XGEN(j)  (2304 + 64 * (j))
#define XB_TOP      3328
#define XB_TOPGEN   3392
#define XCD_BAR_WORDS 3456
#define XB_SPIN_CAP (1u << 18)

__device__ __forceinline__ unsigned xb_ld(unsigned* p)              { return __hip_atomic_load(p, __ATOMIC_RELAXED, __HIP_MEMORY_SCOPE_AGENT); }
__device__ __forceinline__ unsigned xb_add(unsigned* p, unsigned v) { return __hip_atomic_fetch_add(p, v, __ATOMIC_RELAXED, __HIP_MEMORY_SCOPE_AGENT); }
__device__ __forceinline__ unsigned xb_xcc_id() { return (unsigned)__builtin_amdgcn_s_getreg((3 << 11) | 20) & 0xFu; }
#define XB_SPIN(cond, bar) do { unsigned _sp = 0; while (cond) { __builtin_amdgcn_s_sleep(1); \
    if ((++_sp & 255u) == 0u) { if (xb_ld(&(bar)[XB_TMO])) break; if (_sp > XB_SPIN_CAP) { atomicAdd(&(bar)[XB_TMO], 1u); break; } } } } while (0)

struct XcdBarrier {
    unsigned* bar; unsigned x;
    volatile LAS unsigned* st;
};

__device__ __forceinline__ XcdBarrier xcd_barrier_post(unsigned* bar, volatile LAS unsigned* st) {
    XcdBarrier b; b.bar = bar; b.x = xb_xcc_id(); b.st = st;
    if (threadIdx.x == 0) (void)xb_add(&bar[XB_XCNT(b.x)], 1u);
    return b;
}
__device__ __forceinline__ void xcd_barrier_complete(unsigned* bar, unsigned x, unsigned& nloc, unsigned& nx) {
    const unsigned G = gridDim.x * gridDim.y * gridDim.z;
    unsigned sum, cnt, mine, sp = 0u;
    for (;;) {
        sum = 0u; cnt = 0u; mine = 0u;
#pragma unroll
        for (unsigned j = 0; j < 16; ++j) { const unsigned c = xb_ld(&bar[XB_XCNT(j)]); sum += c; cnt += (c > 0u) ? 1u : 0u; mine = (j == x) ? c : mine; }
        if (sum == G) break;
        __builtin_amdgcn_s_sleep(1);
        if ((++sp & 255u) == 0u) { if (xb_ld(&bar[XB_TMO])) break; if (sp > XB_SPIN_CAP) { atomicAdd(&bar[XB_TMO], 1u); break; } }
    }
    nloc = mine > 0u ? mine : 1u; nx = cnt > 0u ? cnt : 1u;
}

__device__ __forceinline__ void xcd_barrier(const XcdBarrier& b) {
    asm volatile("s_waitcnt vmcnt(0)" ::: "memory");
    __syncthreads();
    if (threadIdx.x == 0) {
        unsigned* bar = b.bar;
        __builtin_amdgcn_s_waitcnt(0);
        unsigned nloc = b.st[0], nx = b.st[1];
        if (nloc == 0u) { xcd_barrier_complete(bar, b.x, nloc, nx); b.st[0] = nloc; b.st[1] = nx; }
        const unsigned old = xb_add(&bar[XB_XSUB(b.x)], 1u);
        const unsigned gen = old / nloc;
        if (old + 1u == (gen + 1u) * nloc) {
            __builtin_amdgcn_fence(__ATOMIC_RELEASE, "agent");
            asm volatile("s_waitcnt vmcnt(0)" ::: "memory");
            const unsigned og = xb_add(&bar[XB_TOP], 1u);
            const unsigned tg = og / nx;
            if (og + 1u == (tg + 1u) * nx) xb_add(&bar[XB_TOPGEN], 1u);
            else XB_SPIN(xb_ld(&bar[XB_TOPGEN]) == tg, bar);
            __builtin_amdgcn_fence(__ATOMIC_ACQUIRE, "agent");
            xb_add(&bar[XB_XGEN(b.x)], 1u);
            asm volatile("s_waitcnt vmcnt(0)" ::: "memory");
        } else {
            XB_SPIN(xb_ld(&bar[XB_XGEN(b.x)]) == gen, bar);
            __builtin_amdgcn_fence(__ATOMIC_ACQUIRE, "agent");
            asm volatile("s_waitcnt vmcnt(0)" ::: "memory");
        }
    }
    __syncthreads();
}
namespace att {
constexpr int KSLOT = 6144, VSLOT = 4096;
constexpr int L_K = 0, L_V = 2 * KSLOT, L_WS = L_V + 3 * VSLOT, L_OST = L_WS + 8 * 256, L_CONST = L_OST + 8 * 8192, L_END = L_CONST + 1536;
static_assert(L_END <= RING_BYTES, "attention LDS");
__device__ __forceinline__ int crow(int r, int hi) { return (r & 3) + 8 * (r >> 2) + 4 * hi; }
__device__ __forceinline__ unsigned pkbf(float lo, float hi) { f32x2 v = {lo, hi}; typedef __bf16 bf2 __attribute__((ext_vector_type(2))); bf2 b = __builtin_convertvector(v, bf2); return __builtin_bit_cast(unsigned, b); }
template <bool SAFE>
__device__ __forceinline__ bool attn_unit_impl(const unsigned char* Qw, const unsigned char* __restrict__ Kh, const unsigned char* __restrict__ Vt, bf16_t* Ow, int NT, int nwact, LAS unsigned char* shm) {
    const int tid = otid(), lane = tid & 63, r32 = lane & 31, hi = lane >> 5; const int wid = __builtin_amdgcn_readfirstlane(tid >> 6);
    const bool act = wid < nwact; asm volatile("" : "+s"(NT));
    const int vw = (wid + 2) & 7;
    const unsigned kvo = (unsigned)lane * 768u + (unsigned)(wid < 6 ? wid : 0) * 16u;
    const unsigned vvo = (unsigned)((vw & 3) * 16 + (lane >> 2)) * 64u + (unsigned)(((lane & 3) ^ ((lane >> 4) & 3)) * 16);
    LAS unsigned char* kd0 = shm + L_K + (wid < 6 ? wid : 0) * 1024; LAS unsigned char* vd = shm + L_V + (vw & 3) * 1024;
#define DMA_TILE(t, kslot, vslot) do { \
        if (wid < 6) __builtin_amdgcn_global_load_lds((const unsigned*)(Kh + (size_t)(t) * 64 * 768 + kvo), (LAS unsigned*)(kd0 + (kslot) * KSLOT), 16, 0, 0); \
        if (vw < 4) __builtin_amdgcn_global_load_lds((const unsigned*)(Vt + (size_t)(t) * 4096 + vvo), (LAS unsigned*)(vd + (vslot) * VSLOT), 16, 0, 0); } while (0)
    pg8::i32x8 qa1, qa2, qb1, qb2;
    { const int wq = act ? wid : 0;
      const unsigned char* ra = Qw + (size_t)(wq * 64 + r32) * 768; const unsigned char* rb = ra + (size_t)32 * 768;
      const pg8::i32x4 z4 = {0, 0, 0, 0}, two4 = {0x40, 0, 0, 0};
      const pg8::i32x4 a0_ = *(const pg8::i32x4*)(ra + 32 * hi), a1_ = *(const pg8::i32x4*)(ra + 32 * hi + 16), a2_ = hi ? two4 : *(const pg8::i32x4*)(ra + 64), a3_ = hi ? z4 : *(const pg8::i32x4*)(ra + 80);
      const pg8::i32x4 b0_ = *(const pg8::i32x4*)(rb + 32 * hi), b1_ = *(const pg8::i32x4*)(rb + 32 * hi + 16), b2_ = hi ? two4 : *(const pg8::i32x4*)(rb + 64), b3_ = hi ? z4 : *(const pg8::i32x4*)(rb + 80);
      qa1 = __builtin_shufflevector(a0_, a1_, 0, 1, 2, 3, 4, 5, 6, 7); qa2 = __builtin_shufflevector(a2_, a3_, 0, 1, 2, 3, 4, 5, 6, 7);
      qb1 = __builtin_shufflevector(b0_, b1_, 0, 1, 2, 3, 4, 5, 6, 7); qb2 = __builtin_shufflevector(b2_, b3_, 0, 1, 2, 3, 4, 5, 6, 7); }
    if (tid < 384) ((LAS unsigned*)(shm + L_CONST))[tid] = (tid == 0 || tid == 64) ? 0xC0u : 0u;
    DMA_TILE(0, 0, 0);
    f32x16 oa[2], ob[2]; oa[0] = f32x16{}; oa[1] = f32x16{}; ob[0] = f32x16{}; ob[1] = f32x16{}; float la = 0.f, lb = 0.f, ovf = 0.f;
    const int keyr = 32 * ((r32 >> 2) & 1) + (r32 & 3) + 4 * (r32 >> 3);
    const LAS unsigned char* kp0 = shm + L_K + hi * 2048 + keyr * 16;
    const LAS unsigned char* kp1 = shm + L_K + 4096 + keyr * 16;
    const LAS unsigned char* kcc = shm + L_CONST;
    const int vsw = (r32 >> 2) & 3;
    const LAS unsigned char* vp0 = shm + L_V + r32 * 64 + ((2 * hi) ^ vsw) * 16;
    f32x16 a0, a1, b0, b1; pg8::i32x8 pa = {0, 0, 0, 0, 0, 0, 0, 0}, pb = {0, 0, 0, 0, 0, 0, 0, 0};
    pg8::i32x8 K0, K1, K0x, K1x, V0, V1;
#define MF8(A_, B_, C_) __builtin_amdgcn_mfma_scale_f32_32x32x64_f8f6f4(A_, B_, C_, 0, 0, 0, 0x7F7F7F7F, 0, 0x7F7F7F7F)
#define CAT8(x_, y_) __builtin_shufflevector(x_, y_, 0, 1, 2, 3, 4, 5, 6, 7)
#define LDK(ks_) do { const LAS unsigned char* kb = kp0 + (ks_) * KSLOT; const LAS unsigned char* kc = hi ? kcc : kp1 + (ks_) * KSLOT; \
        const pg8::i32x4 k0a = *(const LAS pg8::i32x4*)(kb), k0b = *(const LAS pg8::i32x4*)(kb + 1024), k1a = *(const LAS pg8::i32x4*)(kb + 256), k1b = *(const LAS pg8::i32x4*)(kb + 1280); \
        const pg8::i32x4 k0c = *(const LAS pg8::i32x4*)(kc), k0d = *(const LAS pg8::i32x4*)(kc + 1024), k1c = *(const LAS pg8::i32x4*)(kc + 256), k1d = *(const LAS pg8::i32x4*)(kc + 1280); \
        K0 = CAT8(k0a, k0b); K1 = CAT8(k1a, k1b); K0x = CAT8(k0c, k0d); K1x = CAT8(k1c, k1d); } while (0)
#define LDV(vs_) do { const LAS unsigned char* va = vp0 + (vs_) * VSLOT; const LAS unsigned char* vb = (const LAS unsigned char*)(uintptr_t)((unsigned)(uintptr_t)va ^ 16u);   \
        const pg8::i32x4 v0a = *(const LAS pg8::i32x4*)(va), v0b = *(const LAS pg8::i32x4*)(vb), v1a = *(const LAS pg8::i32x4*)(va + 2048), v1b = *(const LAS pg8::i32x4*)(vb + 2048); \
        V0 = CAT8(v0a, v0b); V1 = CAT8(v1a, v1b); } while (0)
#define PK4(o_, x_, i_) ({ int w_ = __builtin_amdgcn_cvt_pk_fp8_f32(SAFE ? fminf(x_[i_], 448.f) : x_[i_], SAFE ? fminf(x_[i_ + 1], 448.f) : x_[i_ + 1], o_, false); __builtin_amdgcn_cvt_pk_fp8_f32(SAFE ? fminf(x_[i_ + 2], 448.f) : x_[i_ + 2], SAFE ? fminf(x_[i_ + 3], 448.f) : x_[i_ + 3], w_, true); })
#define SOFT32(x0_, x1_, l_, p_) do { float s_ = 0.f; \
        _Pragma("unroll") for (int r = 0; r < 16; ++r) { x0_[r] = __builtin_amdgcn_exp2f(x0_[r]); x1_[r] = __builtin_amdgcn_exp2f(x1_[r]); s_ += x0_[r] + x1_[r]; } \
        l_ += s_; ovf = fmaxf(ovf, s_); \
        p_ = (pg8::i32x8){PK4(p_[0], x0_, 0), PK4(p_[1], x0_, 4), PK4(p_[2], x0_, 8), PK4(p_[3], x0_, 12), PK4(p_[4], x1_, 0), PK4(p_[5], x1_, 4), PK4(p_[6], x1_, 8), PK4(p_[7], x1_, 12)}; } while (0)
#define TOPSYNC() do { asm volatile("s_waitcnt vmcnt(0)" ::: "memory"); __builtin_amdgcn_s_barrier(); asm volatile("" ::: "memory"); } while (0)
    const f32x16 z16 = {};
    int ks = 0, vs = 0;
    for (int t = 0; t < NT; ++t) {
        TOPSYNC();
        const int vn = (vs == 2) ? 0 : vs + 1;
        if (t + 1 < NT) DMA_TILE(t + 1, ks ^ 1, vn);
        LDK(ks);
        a0 = MF8(K0, qa1, z16); a1 = MF8(K1, qa1, z16); a0 = MF8(K0x, qa2, a0); a1 = MF8(K1x, qa2, a1);
        __builtin_amdgcn_sched_barrier(0);
        b0 = MF8(K0, qb1, z16); b1 = MF8(K1, qb1, z16); b0 = MF8(K0x, qb2, b0); b1 = MF8(K1x, qb2, b1);
        SOFT32(a0, a1, la, pa);
        __builtin_amdgcn_sched_barrier(0); LDV(vs);
        __builtin_amdgcn_sched_barrier(0);
        oa[0] = MF8(pa, V0, oa[0]); oa[1] = MF8(pa, V1, oa[1]);
        SOFT32(b0, b1, lb, pb);
        __builtin_amdgcn_sched_barrier(0);
        ob[0] = MF8(pb, V0, ob[0]); ob[1] = MF8(pb, V1, ob[1]);
        __builtin_amdgcn_sched_barrier(0);
        ks ^= 1; vs = vn;
    }
#undef MF8
#undef CAT8
#undef LDK
#undef LDV
#undef PK4
#undef SOFT32
#undef TOPSYNC
#undef DMA_TILE
    { auto rr = __builtin_amdgcn_permlane32_swap(__float_as_uint(la), __float_as_uint(la), false, false); la = __uint_as_float(rr[0]) + __uint_as_float(rr[1]); }
    { auto rr = __builtin_amdgcn_permlane32_swap(__float_as_uint(lb), __float_as_uint(lb), false, false); lb = __uint_as_float(rr[0]) + __uint_as_float(rr[1]); }
    LAS float* wsf = (LAS float*)(shm + L_WS) + wid * 64;
    if (hi == 0) { wsf[r32] = la; wsf[32 + r32] = lb; }
    if (!SAFE) { if (__builtin_amdgcn_ballot_w64(ovf >= 448.f) != 0 && lane == 0) ((volatile LAS unsigned*)(shm + L_CONST))[380] = 1u; }
    asm volatile("s_waitcnt lgkmcnt(0)" ::: "memory");
    if (act) {
        LAS bf16_t* stg = (LAS bf16_t*)(shm + L_OST) + wid * 4096;
#pragma unroll
        for (int r = 0; r < 16; ++r) { const int orow = crow(r, hi); const float ra = __builtin_amdgcn_rcpf(wsf[orow]), rb = __builtin_amdgcn_rcpf(wsf[32 + orow]);
#pragma unroll
            for (int d0 = 0; d0 < 2; ++d0) { stg[orow * 64 + d0 * 32 + r32] = (bf16_t)(pkbf(oa[d0][r] * ra, 0.f) & 0xffffu); stg[(32 + orow) * 64 + d0 * 32 + r32] = (bf16_t)(pkbf(ob[d0][r] * rb, 0.f) & 0xffffu); } }
        asm volatile("s_waitcnt lgkmcnt(0)" ::: "memory");
#pragma unroll
        for (int i = 0; i < 8; ++i) { const int row = i * 8 + (lane >> 3), ch = lane & 7; const u32x4 v = *(const LAS u32x4*)(stg + row * 64 + ch * 8); *(u32x4*)(Ow + (size_t)(wid * 64 + row) * 512 + ch * 8) = v; }
    }
    asm volatile("s_waitcnt lgkmcnt(0)" ::: "memory"); __builtin_amdgcn_s_barrier(); asm volatile("" ::: "memory");
    bool redo = false;
    if (!SAFE) { redo = __builtin_amdgcn_readfirstlane((int)((volatile LAS unsigned*)(shm + L_CONST))[380]) != 0;
        asm volatile("s_waitcnt lgkmcnt(0)" ::: "memory"); __builtin_amdgcn_s_barrier(); asm volatile("" ::: "memory"); }
    return redo;
}
__device__ __forceinline__ void attn_unit(const unsigned char* Qw, const unsigned char* __restrict__ Kh, const unsigned char* __restrict__ Vt, bf16_t* Ow, int NT, int nwact, LAS unsigned char* shm) {
    if (attn_unit_impl<false>(Qw, Kh, Vt, Ow, NT, nwact, shm)) (void)attn_unit_impl<true>(Qw, Kh, Vt, Ow, NT, nwact, shm);
}
}
namespace fft {
constexpr size_t MIDC = (size_t)4 * 4 * 128 * 64 * 128;
__device__ __forceinline__ bf16x8 mk8(unsigned a, unsigned b, unsigned c, unsigned d) { u32x4 v = {a, b, c, d}; return __builtin_bit_cast(bf16x8, v); }
__device__ __forceinline__ unsigned pkbf(float lo, float hi) { return att::pkbf(lo, hi); }

__device__ __forceinline__ void fft1_phase(const bf16_t* P, bf16_t* MID, LAS unsigned char* lds, int vcu, int G) {
    const int tid = otid(), lane = tid & 63, c_ = lane & 15, q = lane >> 4; const int wid = __builtin_amdgcn_readfirstlane(tid >> 6);
    LAS unsigned char* Dl = lds; LAS unsigned char* ST = lds + 18432;
    int salt; asm volatile("v_mov_b32 %0, 0" : "=v"(salt));
    bf16x8 ccf[4], scf[4];
#pragma unroll
    for (int s = 0; s < 4; ++s) { unsigned cw[4], sw[4];
#pragma unroll
        for (int j = 0; j < 8; j += 2) { float s0, c0, s1, c1; const int m = 16 * wid + c_, ca = 32 * s + 8 * q + j + salt;
            sincospif((float)((ca * m) & 127) * (1.f / 64.f), &s0, &c0); sincospif((float)(((ca + 1) * m) & 127) * (1.f / 64.f), &s1, &c1);
            cw[j >> 1] = pkbf(c0, c1); sw[j >> 1] = pkbf(s0, s1); }
        ccf[s] = mk8(cw[0], cw[1], cw[2], cw[3]); scf[s] = mk8(sw[0], sw[1], sw[2], sw[3]); }
    bf16x8 c64f[4][2], s64f[4][2];
#pragma unroll
    for (int kt = 0; kt < 4; ++kt)
#pragma unroll
        for (int s = 0; s < 2; ++s) { unsigned cw[4], sw[4];
#pragma unroll
            for (int j = 0; j < 8; j += 2) { float s0, c0, s1, c1; const int k1 = 16 * kt + c_ + salt, t1 = 32 * s + (j < 4 ? 4 * q + j : 16 + 4 * q + j - 4);
                sincospif((float)((k1 * t1) & 63) * (1.f / 32.f), &s0, &c0); sincospif((float)((k1 * (t1 + 1)) & 63) * (1.f / 32.f), &s1, &c1);
                cw[j >> 1] = pkbf(c0, c1); sw[j >> 1] = pkbf(s0, s1); }
            c64f[kt][s] = mk8(cw[0], cw[1], cw[2], cw[3]); s64f[kt][s] = mk8(sw[0], sw[1], sw[2], sw[3]); }
    u32x4 nd0, nd1;
    { const int it0 = vcu < 2048 ? vcu : 0; const int b = it0 >> 9, g = (it0 >> 7) & 3, t2 = it0 & 127; const int row = tid >> 3, ch = tid & 7;
      const bf16_t* src = P + ((size_t)b * SB + 128 * row + t2) * INW + 544 + 128 * g + ch * 16; nd0 = *(const u32x4*)src; nd1 = *(const u32x4*)(src + 8); }
    for (int item = vcu; item < 2048; item += G) {
        const int b = item >> 9, g = (item >> 7) & 3, t2 = item & 127;
        { const int row = tid >> 3, ch = tid & 7;
          *(LAS u32x4*)(Dl + row * 288 + ch * 32) = nd0; *(LAS u32x4*)(Dl + row * 288 + ch * 32 + 16) = nd1;
          const int nit = (item + G < 2048) ? item + G : item; const int nb = nit >> 9, ng = (nit >> 7) & 3, nt2 = nit & 127;
          const bf16_t* src = P + ((size_t)nb * SB + 128 * row + nt2) * INW + 544 + 128 * ng + ch * 16; nd0 = *(const u32x4*)src; nd1 = *(const u32x4*)(src + 8); }
        __syncthreads();
        f32x4 aA[4], aB[4];
#pragma unroll
        for (int i = 0; i < 4; ++i) { aA[i] = (f32x4){0.f, 0.f, 0.f, 0.f}; aB[i] = (f32x4){0.f, 0.f, 0.f, 0.f}; }
#pragma unroll
        for (int s = 0; s < 4; ++s)
#pragma unroll
            for (int i = 0; i < 4; ++i) { const bf16x8 af = *(const LAS bf16x8*)(Dl + (16 * i + c_) * 288 + (32 * s + 8 * q) * 2);
                aA[i] = __builtin_amdgcn_mfma_f32_16x16x32_bf16(af, ccf[s], aA[i], 0, 0, 0); aB[i] = __builtin_amdgcn_mfma_f32_16x16x32_bf16(af, scf[s], aB[i], 0, 0, 0); }
        unsigned xa[4][2], xb[4][2];
#pragma unroll
        for (int i = 0; i < 4; ++i) { xa[i][0] = pkbf(aA[i][0], aA[i][1]); xa[i][1] = pkbf(aA[i][2], aA[i][3]); xb[i][0] = pkbf(aB[i][0], aB[i][1]); xb[i][1] = pkbf(aB[i][2], aB[i][3]); }
        bf16x8 fA[2], fB[2], fNB[2];
#pragma unroll
        for (int s = 0; s < 2; ++s) { fA[s] = mk8(xa[2 * s][0], xa[2 * s][1], xa[2 * s + 1][0], xa[2 * s + 1][1]); fB[s] = mk8(xb[2 * s][0], xb[2 * s][1], xb[2 * s + 1][0], xb[2 * s + 1][1]);
            fNB[s] = mk8(xb[2 * s][0] ^ 0x80008000u, xb[2 * s][1] ^ 0x80008000u, xb[2 * s + 1][0] ^ 0x80008000u, xb[2 * s + 1][1] ^ 0x80008000u); }
#pragma unroll
        for (int kt = 0; kt < 4; ++kt) { f32x4 yr = (f32x4){0.f, 0.f, 0.f, 0.f}, wi = (f32x4){0.f, 0.f, 0.f, 0.f};
#pragma unroll
            for (int s = 0; s < 2; ++s) {
                yr = __builtin_amdgcn_mfma_f32_16x16x32_bf16(fA[s], c64f[kt][s], yr, 0, 0, 0); yr = __builtin_amdgcn_mfma_f32_16x16x32_bf16(fNB[s], s64f[kt][s], yr, 0, 0, 0);
                wi = __builtin_amdgcn_mfma_f32_16x16x32_bf16(fB[s], c64f[kt][s], wi, 0, 0, 0); wi = __builtin_amdgcn_mfma_f32_16x16x32_bf16(fA[s], s64f[kt][s], wi, 0, 0, 0); }
            const int k1 = 16 * kt + c_; float ts, tr; sincospif((float)(k1 * t2) * (1.f / 4096.f), &ts, &tr);
            const f32x4 ypr = yr * tr - wi * ts, wpi = yr * ts + wi * tr;
            LAS unsigned char* sp = ST + k1 * 272 + (16 * wid + 4 * q) * 2;
            *(LAS u32x2*)sp = (u32x2){pkbf(ypr[0], ypr[1]), pkbf(ypr[2], ypr[3])}; *(LAS u32x2*)(sp + 17408) = (u32x2){pkbf(wpi[0], wpi[1]), pkbf(wpi[2], wpi[3])}; }
        __syncthreads();
#pragma unroll
        for (int p = 0; p < 4; ++p) { const int idx = p * 512 + tid, comp = idx >> 10, rem = idx & 1023, k1 = rem >> 4, ch = rem & 15;
            const u32x4 v = *(const LAS u32x4*)(ST + comp * 17408 + k1 * 272 + ch * 16);
            *(u32x4*)(MID + comp * MIDC + ((((size_t)b * 4 + g) * 128 + t2) * 64 + k1) * 128 + ch * 8) = v; }
    }
    __syncthreads();
}

__device__ __forceinline__ void fft2_phase(const bf16_t* MID, bf16_t* FOUR, LAS unsigned char* lds, int vcu, int G) {
    const int tid = otid(), lane = tid & 63, r32 = lane & 31, hi = lane >> 5; const int wid = __builtin_amdgcn_readfirstlane(tid >> 6), kt = wid & 3, mh = wid >> 2;
    LAS unsigned char* DT = lds; LAS unsigned char* ST = lds + 65536;
    int salt; asm volatile("v_mov_b32 %0, 0" : "=v"(salt));
    bf16x8 cf[8], nsf[8];
#pragma unroll
    for (int s = 0; s < 8; ++s) { unsigned cw[4], sw[4];
#pragma unroll
        for (int j = 0; j < 8; j += 2) { float s0, c0, s1, c1; const int k2 = 32 * kt + r32 + salt, t2 = 16 * s + (j < 4 ? 4 * hi + j : 8 + 4 * hi + j - 4);
            sincospif((float)((k2 * t2) & 127) * (1.f / 64.f), &s0, &c0); sincospif((float)((k2 * (t2 + 1)) & 127) * (1.f / 64.f), &s1, &c1);
            cw[j >> 1] = pkbf(c0, c1); sw[j >> 1] = pkbf(-s0, -s1); }
        cf[s] = mk8(cw[0], cw[1], cw[2], cw[3]); nsf[s] = mk8(sw[0], sw[1], sw[2], sw[3]); }
    const int vb = (int)(unsigned)(uintptr_t)DT + mh * 16384 + ((lane >> 4) & 1) * 32 + (lane & 3) * 8 + (4 * hi + ((lane & 15) >> 2)) * 64;
    for (int item = vcu; item < 1024; item += G) {
        const int b = item >> 8, g = (item >> 6) & 3, k1 = item & 63;
        u32x4 dv[2][4];
#pragma unroll
        for (int comp = 0; comp < 2; ++comp)
#pragma unroll
            for (int i = 0; i < 4; ++i) { const int idx = i * 512 + tid, t2 = idx >> 4, ch = idx & 15;
                dv[comp][i] = *(const u32x4*)(MID + comp * MIDC + ((((size_t)b * 4 + g) * 128 + t2) * 64 + k1) * 128 + ch * 8); }
#pragma unroll
        for (int comp = 0; comp < 2; ++comp)
#pragma unroll
            for (int i = 0; i < 4; ++i) { const int idx = i * 512 + tid, t2 = idx >> 4, ch = idx & 15;
                *(LAS u32x4*)(DT + comp * 32768 + (ch >> 2) * 8192 + (t2 >> 4) * 1024 + (t2 & 15) * 64 + (ch & 3) * 16) = dv[comp][i]; }
        __syncthreads();
        f32x16 acc[2]; acc[0] = f32x16{}; acc[1] = f32x16{};
#pragma unroll
        for (int mql = 0; mql < 2; ++mql)
#pragma unroll
            for (int s = 0; s < 8; ++s) { s16x4 l0, h0, l1, h1;
                asm volatile("ds_read_b64_tr_b16 %0,%1 offset:%c2" : "=&v"(l0) : "v"(vb), "i"(mql * 8192 + s * 1024) : "memory");
                asm volatile("ds_read_b64_tr_b16 %0,%1 offset:%c2" : "=&v"(h0) : "v"(vb), "i"(mql * 8192 + s * 1024 + 512) : "memory");
                asm volatile("ds_read_b64_tr_b16 %0,%1 offset:%c2" : "=&v"(l1) : "v"(vb), "i"(32768 + mql * 8192 + s * 1024) : "memory");
                asm volatile("ds_read_b64_tr_b16 %0,%1 offset:%c2" : "=&v"(h1) : "v"(vb), "i"(32768 + mql * 8192 + s * 1024 + 512) : "memory");
                asm volatile("s_waitcnt lgkmcnt(0)" ::: "memory"); __builtin_amdgcn_sched_barrier(0);
                const bf16x8 a0 = (bf16x8){l0[0], l0[1], l0[2], l0[3], h0[0], h0[1], h0[2], h0[3]}, a1 = (bf16x8){l1[0], l1[1], l1[2], l1[3], h1[0], h1[1], h1[2], h1[3]};
                acc[mql] = __builtin_amdgcn_mfma_f32_32x32x16_bf16(a0, cf[s], acc[mql], 0, 0, 0); acc[mql] = __builtin_amdgcn_mfma_f32_32x32x16_bf16(a1, nsf[s], acc[mql], 0, 0, 0); }
        const int k2 = 32 * kt + r32;
#pragma unroll
        for (int mql = 0; mql < 2; ++mql)
#pragma unroll
            for (int a = 0; a < 4; ++a) { const int m = 32 * (2 * mh + mql) + 8 * a + 4 * hi; const float sc = 1.f / 1024.f;
                *(LAS u32x2*)(ST + k2 * 272 + m * 2) = (u32x2){pkbf(acc[mql][4 * a] * sc, acc[mql][4 * a + 1] * sc), pkbf(acc[mql][4 * a + 2] * sc, acc[mql][4 * a + 3] * sc)}; }
        __syncthreads();
#pragma unroll
        for (int p = 0; p < 4; ++p) { const int idx = p * 512 + tid, kk = idx >> 4, ch = idx & 15;
            const u32x4 v = *(const LAS u32x4*)(ST + kk * 272 + ch * 16);
            *(u32x4*)(FOUR + ((size_t)b * SB + k1 + 64 * kk) * 512 + g * 128 + ch * 8) = v; }
    }
    __syncthreads();
}

__device__ __forceinline__ void ctxfour_phase(const bf16_t* P, bf16_t* FOUR, LAS unsigned char* lds, int vcu, int G) {
    const int tid = otid(), lane = tid & 63, fr = lane & 15, fq = lane >> 4; const int wid = __builtin_amdgcn_readfirstlane(tid >> 6);
    LAS unsigned short* Dl = (LAS unsigned short*)lds;
    LAS float* ct = (LAS float*)(lds + 69632); LAS float* st = ct + 256;
    LAS unsigned short* Zl = (LAS unsigned short*)(lds + 71680);
    LAS unsigned short* Ol = (LAS unsigned short*)(lds + 71680 + 8448);
    if (tid < 256) { float s, c; sincospif((float)tid * (1.f / 128.f), &s, &c); ct[tid] = c; st[tid] = s; }
    for (int item = vcu; item < 256; item += G) {
        const int b = item >> 6, g = (item >> 4) & 3, mc = item & 15, m0 = 8 * mc;
        __syncthreads();
#pragma unroll
        for (int i = 0; i < 8; ++i) { const int idx = i * 512 + tid, t = idx >> 4, ch = idx & 15;
            const u32x4 v = *(const u32x4*)(P + ((size_t)b * SB + SEQ + t) * INW + 544 + 128 * g + ch * 8);
            *(LAS u32x4*)((LAS unsigned char*)Dl + t * 272 + ch * 16) = v; }
        __syncthreads();
        bf16x8 tw[4];
        { const int m = m0 + (fr & 7); const LAS float* tb = (fr < 8) ? ct : st;
#pragma unroll
          for (int ks = 0; ks < 4; ++ks) { float v[8];
#pragma unroll
              for (int i = 0; i < 8; ++i) v[i] = tb[(2 * m * (32 * ks + 8 * fq + i)) & 255];
              tw[ks] = mk8(pkbf(v[0], v[1]), pkbf(v[2], v[3]), pkbf(v[4], v[5]), pkbf(v[6], v[7])); } }
#pragma unroll
        for (int tt = 0; tt < 2; ++tt) { const int tile = 2 * wid + tt; f32x4 acc = {0.f, 0.f, 0.f, 0.f};
#pragma unroll
            for (int ks = 0; ks < 4; ++ks) { const bf16x8 a = *(const LAS bf16x8*)((const LAS unsigned char*)Dl + (16 * tile + fr) * 272 + (32 * ks + 8 * fq) * 2);
                acc = __builtin_amdgcn_mfma_f32_16x16x32_bf16(a, tw[ks], acc, 0, 0, 0); }
            *(LAS u32x2*)(Zl + fr * 264 + 16 * tile + 4 * fq) = (u32x2){pkbf(acc[0], acc[1]), pkbf(acc[2], acc[3])}; }
        __syncthreads();
#pragma unroll 1
        for (int kt = 0; kt < 2; ++kt) { const int tile = 2 * wid + kt, k = 16 * tile + fr; f32x4 acc = {0.f, 0.f, 0.f, 0.f};
#pragma unroll 4
            for (int ks = 0; ks < 16; ++ks) { const int part = ks >> 3, t0 = 32 * (ks & 7) + 8 * fq; float v[8];
#pragma unroll
                for (int i = 0; i < 8; ++i) { const int idx = (k * (t0 + i)) & 255; v[i] = part ? -st[idx] : ct[idx]; }
                const bf16x8 a = mk8(pkbf(v[0], v[1]), pkbf(v[2], v[3]), pkbf(v[4], v[5]), pkbf(v[6], v[7]));
                const bf16x8 bz = *(const LAS bf16x8*)(Zl + (part * 8 + (fr & 7)) * 264 + t0);
                acc = __builtin_amdgcn_mfma_f32_16x16x32_bf16(a, bz, acc, 0, 0, 0); }
            const float sc = 0.005524271728019903f;
            if (fr < 8) {
#pragma unroll
                for (int r = 0; r < 4; ++r) Ol[(16 * tile + 4 * fq + r) * 8 + fr] = (unsigned short)(pkbf(acc[r] * sc, 0.f) & 0xffffu); } }
        __syncthreads();
        if (tid < 256) *(u32x4*)(FOUR + ((size_t)b * SB + SEQ + tid) * 512 + g * 128 + m0) = *(const LAS u32x4*)(Ol + tid * 8);
    }
    __syncthreads();
}
}
__device__ __forceinline__ unsigned pk2(float lo, float hi) { return att::pkbf(lo, hi); }
__device__ __forceinline__ float c448(float x) { return __builtin_amdgcn_fmed3f(x, -448.f, 448.f); }
__device__ __forceinline__ unsigned pk4f8(float a, float b, float c, float d) { int w = 0; w = __builtin_amdgcn_cvt_pk_fp8_f32(c448(a), c448(b), w, false); w = __builtin_amdgcn_cvt_pk_fp8_f32(c448(c), c448(d), w, true); return (unsigned)w; }

__device__ __forceinline__ void tr_item(const float* W, int ldw, int k0, int n0, bf16_t* WT, int ldk, int orow0, const float* ks, LAS float* scr, int lane) {
#pragma unroll 8
    for (int i = 0; i < 32; ++i) { const int kk = 2 * i + (lane >> 5); float v = W[(size_t)(k0 + kk) * ldw + n0 + (lane & 31)]; if (ks) v *= ks[k0 + kk]; scr[kk * 33 + (lane & 31)] = v; }
    LDS_WAIT(); asm volatile("" ::: "memory");
    const int c = lane & 7;
#pragma unroll
    for (int j = 0; j < 4; ++j) { const int n = (lane >> 3) + 8 * j; const LAS float* s = scr + (8 * c) * 33 + n;
        u32x4 o; o.x = pk2(s[0 * 33], s[1 * 33]); o.y = pk2(s[2 * 33], s[3 * 33]); o.z = pk2(s[4 * 33], s[5 * 33]); o.w = pk2(s[6 * 33], s[7 * 33]);
        *(u32x4*)(WT + (size_t)(orow0 + n) * ldk + k0 + 8 * c) = o; }
    LDS_WAIT(); asm volatile("" ::: "memory");
}
__device__ __forceinline__ void conv_mat(const float* W, int K, int N, bf16_t* WT, int mode, const float* ks, int& off, int gw, int NGW, LAS float* scr, int lane) {
    const int nnb = N / 32, items = (K / 64) * nnb;
    const int start = (gw + NGW - (off % NGW)) % NGW;
    for (int it = start; it < items; it += NGW) { const int kb = it / nnb, nb = it - kb * nnb, n0 = nb * 32;
        const int orow0 = (mode == 0) ? n0 : 256 * (n0 >> 7) + 128 * (mode - 1) + (n0 & 127);
        tr_item(W, N, kb * 64, n0, WT, K, orow0, ks, scr, lane); }
    off += items;
}

__device__ __forceinline__ void conv_mat_f8(const float* W, int K, int N, unsigned char* WT, float sc, int& off, int gw, int NGW, LAS float* scr, int lane) {
    const int nnb = N / 32, items = (K / 64) * nnb;
    const int start = (gw + NGW - (off % NGW)) % NGW;
    for (int it = start; it < items; it += NGW) { const int kb = it / nnb, nb = it - kb * nnb, n0 = nb * 32;
        const float* p = W + (size_t)(kb * 64 + (lane >> 5)) * N + n0 + (lane & 31); const size_t st = (size_t)2 * N; LAS float* sq = scr + (lane >> 5) * 33 + (lane & 31);
#pragma unroll 8
        for (int i = 0; i < 32; ++i) { sq[(2 * i) * 33] = *p * sc; p += st; }
        LDS_WAIT(); asm volatile("" ::: "memory");
        const int n = lane >> 1, hf = lane & 1; const LAS float* sp = scr + (32 * hf) * 33 + n; int pk[8];
#pragma unroll
        for (int j = 0; j < 8; ++j) { int w = 0; w = __builtin_amdgcn_cvt_pk_fp8_f32(sp[(4 * j) * 33], sp[(4 * j + 1) * 33], w, false); w = __builtin_amdgcn_cvt_pk_fp8_f32(sp[(4 * j + 2) * 33], sp[(4 * j + 3) * 33], w, true); pk[j] = w; }
        u32x4* dst = (u32x4*)(WT + (size_t)(n0 + n) * K + kb * 64 + 32 * hf);
        dst[0] = (u32x4){(unsigned)pk[0], (unsigned)pk[1], (unsigned)pk[2], (unsigned)pk[3]}; dst[1] = (u32x4){(unsigned)pk[4], (unsigned)pk[5], (unsigned)pk[6], (unsigned)pk[7]};
        LDS_WAIT(); asm volatile("" ::: "memory"); }
    off += items;
}
constexpr int QW_BUF = 69632, QW_STRIDE = 1040, QW_CM = QW_BUF + 32 * QW_STRIDE;
static_assert(QW_CM + 1024 <= RING_BYTES, "quantiser LDS");
__device__ __forceinline__ void quant_wg(const float* W, int N, signed char* WT, float* cm, int mode, int& off, int vcu, int G, LAS unsigned char* lds, int tid) {
    const int items = N / 32, start = (vcu + G - (off % G)) % G;
    const int w = __builtin_amdgcn_readfirstlane(tid >> 6), lane = tid & 63, r = lane >> 3, c = lane & 7;
    LAS float* cml = (LAS float*)(lds + QW_CM);
    for (int it = start; it < items; it += G) { const int n0 = it * 32;
        const int orow0 = (mode == 0) ? n0 : 256 * (n0 >> 7) + 128 * (mode - 1) + (n0 & 127);
        const float* src = W + (size_t)(128 * w + 4 * r) * N + n0 + 4 * c;
        f32x4 v[16];
#pragma unroll
        for (int b = 0; b < 4; ++b)
#pragma unroll
            for (int dk = 0; dk < 4; ++dk) v[4 * b + dk] = *(const f32x4*)(src + (size_t)(32 * b + dk) * N);
        f32x4 m = {0.f, 0.f, 0.f, 0.f};
#pragma unroll
        for (int i = 0; i < 16; ++i) { m.x = fmaxf(m.x, fabsf(v[i].x)); m.y = fmaxf(m.y, fabsf(v[i].y)); m.z = fmaxf(m.z, fabsf(v[i].z)); m.w = fmaxf(m.w, fabsf(v[i].w)); }
#pragma unroll
        for (int o = 8; o < 64; o <<= 1) { m.x = fmaxf(m.x, __shfl_xor(m.x, o)); m.y = fmaxf(m.y, __shfl_xor(m.y, o)); m.z = fmaxf(m.z, __shfl_xor(m.z, o)); m.w = fmaxf(m.w, __shfl_xor(m.w, o)); }
        if (r == 0) *(LAS f32x4*)(cml + w * 32 + 4 * c) = m;
        __syncthreads();
        f32x4 mx = *(const LAS f32x4*)(cml + 4 * c);
#pragma unroll
        for (int ww = 1; ww < 8; ++ww) { const f32x4 t = *(const LAS f32x4*)(cml + ww * 32 + 4 * c); mx.x = fmaxf(mx.x, t.x); mx.y = fmaxf(mx.y, t.y); mx.z = fmaxf(mx.z, t.z); mx.w = fmaxf(mx.w, t.w); }
        if (w == 0 && r == 0) *(f32x4*)(cm + orow0 + 4 * c) = mx;
        const f32x4 inv = {mx.x > 0.f ? 127.f / mx.x : 0.f, mx.y > 0.f ? 127.f / mx.y : 0.f, mx.z > 0.f ? 127.f / mx.z : 0.f, mx.w > 0.f ? 127.f / mx.w : 0.f};
        LAS unsigned char* img = lds + QW_BUF + 128 * w + 4 * r;
#pragma unroll
        for (int b = 0; b < 4; ++b) {
#define QW_PK(comp_, j_) { const int q0 = (int)rintf(v[4 * b].comp_ * inv.comp_), q1 = (int)rintf(v[4 * b + 1].comp_ * inv.comp_), q2 = (int)rintf(v[4 * b + 2].comp_ * inv.comp_), q3 = (int)rintf(v[4 * b + 3].comp_ * inv.comp_); \
            *(LAS unsigned*)(img + (4 * c + j_) * QW_STRIDE + 32 * b) = (unsigned)(q0 & 255) | ((unsigned)(q1 & 255) << 8) | ((unsigned)(q2 & 255) << 16) | ((unsigned)(q3 & 255) << 24); }
            QW_PK(x, 0) QW_PK(y, 1) QW_PK(z, 2) QW_PK(w, 3)
#undef QW_PK
        }
        __syncthreads();
        { const int n = tid >> 4, ch = tid & 15; const LAS u32x4* sp = (const LAS u32x4*)(lds + QW_BUF + n * QW_STRIDE + ch * 64); u32x4* dp = (u32x4*)(WT + (size_t)(orow0 + n) * 1024 + ch * 64);
          const u32x4 x0 = sp[0], x1 = sp[1], x2 = sp[2], x3 = sp[3]; dp[0] = x0; dp[1] = x1; dp[2] = x2; dp[3] = x3; }
        __syncthreads();
    }
    off += items;
}

struct Args { const float* in[25]; float* out; unsigned char* ws; int pad0, pad1; };
typedef const Args __attribute__((address_space(4))) KArgs;
__device__ __forceinline__ KArgs* KA() { KArgs* p = (KArgs*)__builtin_amdgcn_kernarg_segment_ptr(); asm volatile("" : "+s"(p)); return p; }
struct Ctx {
    float* out; unsigned char* ws;
    int tid, lane, wave, vcu, G, gw, NGW;
    LAS unsigned char* lds;
};
enum { I_X = 0, I_C, I_CTX, I_CCTX, I_WADA, I_BADA, I_NORM1, I_WIN, I_QLN, I_KVLN, I_WUQ, I_WUKV, I_QN, I_KN, I_ONA, I_ONF, I_WOUT, I_NORM2, I_FG, I_FU, I_FD, I_WR, I_MG, I_MU, I_MD };

__device__ __forceinline__ void conv_dense_weights(const Ctx& C) {
    KArgs* A = KA();
    LAS float* scr = (LAS float*)(C.lds + C.wave * 8448); int off = 0;
    for (int l = 0; l < DEPTH; ++l) {
        conv_mat(A->in[I_WUQ] + (size_t)l * 256 * 768, 256, 768, (bf16_t*)(C.ws + WS_WUQ) + (size_t)l * 768 * 256, 0, A->in[I_QLN] + l * 256, off, C.gw, C.NGW, scr, C.lane);
        conv_mat(A->in[I_WUKV] + (size_t)l * 256 * 1024, 256, 1024, (bf16_t*)(C.ws + WS_WUKV) + (size_t)l * 1024 * 256, 0, A->in[I_KVLN] + l * 256, off, C.gw, C.NGW, scr, C.lane);
    }
    for (int i = 0; i < 2; ++i) {
        conv_mat_f8(A->in[I_FD] + (size_t)i * FFN * DM, FFN, DM, (unsigned char*)(C.ws + WS_WD) + (size_t)i * DM * FFN, WD_SCALE, off, C.gw, C.NGW, scr, C.lane);
    }
    for (int l = 0; l < DEPTH; ++l) { u32x4* z = (u32x4*)((signed char*)(C.ws + WS_WIN) + ((size_t)l * 1280 + INW) * DM);
        for (int i = C.gw * 64 + C.lane; i < 224 * DM / 16; i += C.NGW * 64) z[i] = (u32x4){0u, 0u, 0u, 0u}; }
}
__device__ __forceinline__ void conv_moe(const Ctx& C, int i) {
    KArgs* A = KA();
    LAS float* scr = (LAS float*)(C.lds + C.wave * 8448); int off = 0, offw = 0;
    float* cm = (float*)(C.ws + WS_SCL + SCL_SWM) + (size_t)i * 8 * 7168;
    for (int e = 0; e < NE; ++e) {
        const size_t wo = ((size_t)i * NE + e) * DM * MFF;
        quant_wg(A->in[I_MG] + wo, MFF, (signed char*)(C.ws + WS_MGU) + (size_t)e * 7168 * DM, cm + e * 7168, 1, offw, C.vcu, C.G, C.lds, C.tid);
        quant_wg(A->in[I_MU] + wo, MFF, (signed char*)(C.ws + WS_MGU) + (size_t)e * 7168 * DM, cm + e * 7168, 2, offw, C.vcu, C.G, C.lds, C.tid);
    }
    for (int e = 0; e < NE; ++e) {
        const size_t wo = ((size_t)i * NE + e) * DM * MFF;
        conv_mat_f8(A->in[I_MD] + wo, MFF, DM, (unsigned char*)(C.ws + WS_MD) + (size_t)e * DM * MFF, WD_SCALE, off, C.gw, C.NGW, scr, C.lane);
    }
}
__device__ __forceinline__ void conv_gu(const Ctx& C) {
    KArgs* A = KA(); int offw = 0;
    for (int i = 0; i < 2; ++i) { float* cm = (float*)(C.ws + WS_SCL + SCL_SWD) + i * 5632;
        quant_wg(A->in[I_FG] + (size_t)i * DM * FFN, FFN, (signed char*)(C.ws + WS_WGU) + (size_t)i * 5632 * DM, cm, 1, offw, C.vcu, C.G, C.lds, C.tid);
        quant_wg(A->in[I_FU] + (size_t)i * DM * FFN, FFN, (signed char*)(C.ws + WS_WGU) + (size_t)i * 5632 * DM, cm, 2, offw, C.vcu, C.G, C.lds, C.tid); }
    for (int l = 0; l < DEPTH; ++l) quant_wg(A->in[I_WOUT] + (size_t)l * DM * DM, DM, (signed char*)(C.ws + WS_WOUT) + (size_t)l * DM * DM, (float*)(C.ws + WS_SCL + SCL_SWO) + l * DM, 0, offw, C.vcu, C.G, C.lds, C.tid);
    for (int l = 0; l < DEPTH; ++l) quant_wg(A->in[I_WIN] + (size_t)l * DM * INW, INW, (signed char*)(C.ws + WS_WIN) + (size_t)l * 1280 * DM, (float*)(C.ws + WS_SCL + SCL_SWI) + l * 1280, 0, offw, C.vcu, C.G, C.lds, C.tid);
}
__device__ __forceinline__ void ada_phase(const Ctx& C) {
    KArgs* A = KA();
    LAS float* sl = (LAS float*)C.lds; LAS float* red = sl + 5 * 1024;
    for (int i = C.tid; i < 5 * 1024; i += 512) { const int r = i >> 10, k = i & 1023; const float v = (r < 4) ? A->in[I_C][r * 1024 + k] : A->in[I_CCTX][k]; sl[i] = v / (1.f + expf(-v)); }
    __syncthreads();
    float* mod = (float*)(C.ws + WS_MOD);
    for (int it = C.vcu; it < 4 * 64; it += C.G) { const int l = it >> 6, n0 = (it & 63) * 96, col = C.tid & 127, kq = C.tid >> 7; const int cc_ = col < 96 ? col : 95;
        const float* w = A->in[I_WADA] + ((size_t)l * DM + kq * 256) * 6144 + n0 + cc_; const LAS float* s = sl + kq * 256;
        float a0 = 0.f, a1 = 0.f, a2 = 0.f, a3 = 0.f, a4 = 0.f;
        for (int k = 0; k < 256; k += 16) { float wv[16];
#pragma unroll
            for (int j = 0; j < 16; ++j) wv[j] = w[(size_t)(k + j) * 6144];
#pragma unroll
            for (int j = 0; j < 16; ++j) { a0 += s[k + j] * wv[j]; a1 += s[1024 + k + j] * wv[j]; a2 += s[2048 + k + j] * wv[j]; a3 += s[3072 + k + j] * wv[j]; a4 += s[4096 + k + j] * wv[j]; } }
        red[(kq * 5 + 0) * 128 + col] = a0; red[(kq * 5 + 1) * 128 + col] = a1; red[(kq * 5 + 2) * 128 + col] = a2; red[(kq * 5 + 3) * 128 + col] = a3; red[(kq * 5 + 4) * 128 + col] = a4;
        __syncthreads();
        for (int i = C.tid; i < 5 * 128; i += 512) { const int r = i >> 7, cc = i & 127; if (cc >= 96) continue;
            mod[((size_t)l * 5 + r) * 6144 + n0 + cc] = ((red[(0 * 5 + r) * 128 + cc] + red[(1 * 5 + r) * 128 + cc]) + (red[(2 * 5 + r) * 128 + cc] + red[(3 * 5 + r) * 128 + cc])) + A->in[I_BADA][l * 6144 + n0 + cc]; }
        __syncthreads();
    }
}
__device__ __forceinline__ size_t res_row_off(int row, int& mr, bool& isctx) {
    const int b = row / SB, j = row - b * SB; isctx = j >= SEQ; mr = isctx ? 4 : b;
    return isctx ? ((size_t)b * CTXL + (j - SEQ)) * DM : ((size_t)b * SEQ + j) * DM;
}
template <bool F32> __device__ __forceinline__ f32x4 ld4(const void* rowp, int idx) {
    if constexpr (F32) return ((const f32x4*)rowp)[idx];
    else { const u32x2 v = ((const u32x2*)rowp)[idx]; return (f32x4){bflo(v.x), bfhi(v.x), bflo(v.y), bfhi(v.y)}; }
}
template <bool F32> __device__ __forceinline__ void st4(void* rowp, int idx, f32x4 v) {
    if constexpr (F32) ((f32x4*)rowp)[idx] = v; else ((u32x2*)rowp)[idx] = (u32x2){pk2(v.x, v.y), pk2(v.z, v.w)};
}
template <bool ROUTE, bool I8OUT, bool SRC_F32>
__device__ __forceinline__ void norm_phase(const Ctx& C, const void* lat, const void* ctx, const float* gain, const float* modl, int shift_off, int scale_off, bool with_ctx, const float* wr, bf16_t* ctx_copy = nullptr, int nparts = 0) {
    bf16_t* H = (bf16_t*)(C.ws + WS_H);
    LAS float* wrl = (LAS float*)C.lds;
    LAS int* le = (LAS int*)(C.lds + 32768);
    int* RE = (int*)(C.ws + WS_META + MT_RE); float* RW = (float*)(C.ws + WS_META + MT_RW); int* LR = (int*)(C.ws + WS_META + MT_LR); int* BC = (int*)(C.ws + WS_META + MT_BC);
    if (ROUTE) { for (int i = C.tid; i < 8192; i += 512) wrl[i] = wr[i]; __syncthreads(); }
    f32x4 wreg[4][8];
    if (ROUTE) {
#pragma unroll
        for (int j = 0; j < 4; ++j)
#pragma unroll
            for (int q = 0; q < 8; ++q) wreg[j][q] = *(const LAS f32x4*)(wrl + (4 * C.lane + 256 * j) * 8 + 4 * q); }
    const int chunk = TT / 256, row0 = blockIdx.x * chunk;
    for (int rr = C.wave; rr < chunk; rr += 8) {
        const int row = row0 + rr; int mr; bool isctx; const size_t ro = res_row_off(row, mr, isctx);
        const unsigned char* xr = (const unsigned char*)(isctx ? ctx : lat) + ro * (SRC_F32 ? 4 : 2);
        if (isctx && !with_ctx) { if (ROUTE && C.lane == 0) { le[rr * 2] = -1; le[rr * 2 + 1] = -1; RE[row * 2] = -1; RE[row * 2 + 1] = -1; } continue; }
        f32x4 v[4]; float ss = 0.f;
#pragma unroll
        for (int j = 0; j < 4; ++j) { v[j] = ld4<SRC_F32>(xr, C.lane + 64 * j); ss += (v[j].x * v[j].x + v[j].y * v[j].y) + (v[j].z * v[j].z + v[j].w * v[j].w); }
        if (ctx_copy && isctx) {
            const float* cp = (const float*)(C.ws + WS_CPART) + ro;
            for (int p = 0; p < nparts; ++p) { const f32x4* pv = (const f32x4*)(cp + (size_t)p * NB * CTXL * DM) + C.lane;
#pragma unroll
                for (int j = 0; j < 4; ++j) v[j] = v[j] + pv[64 * j]; }
            ss = 0.f;
#pragma unroll
            for (int j = 0; j < 4; ++j) { st4<false>(ctx_copy + ro, C.lane + 64 * j, v[j]); ss += (v[j].x * v[j].x + v[j].y * v[j].y) + (v[j].z * v[j].z + v[j].w * v[j].w); } }
        const float rinv = rsqrtf(wave_sum(ss) * (1.f / DM) + EPS);
        const f32x4* gv = (const f32x4*)gain + C.lane; const f32x4* shv = (const f32x4*)(modl + (size_t)mr * 6144 + shift_off) + C.lane; const f32x4* scv = (const f32x4*)(modl + (size_t)mr * 6144 + scale_off) + C.lane;
        u32x2* o8 = (u32x2*)(H + (size_t)row * DM) + C.lane;
        unsigned* o4 = (unsigned*)((signed char*)H + (size_t)row * DM) + C.lane;
        f32x4 hq[4]; float amax = 0.f;
        float lg[8];
        if (ROUTE) {
#pragma unroll
            for (int e = 0; e < 8; ++e) lg[e] = 0.f; }
#pragma unroll
        for (int j = 0; j < 4; ++j) { const f32x4 g = gv[64 * j], sh = shv[64 * j], sc = scv[64 * j];
            const f32x4 y = (v[j] * rinv) * g; const f32x4 h = y * (sc + 1.f) + sh;
            if (I8OUT) { hq[j] = h; amax = fmaxf(fmaxf(amax, fmaxf(fabsf(h.x), fabsf(h.y))), fmaxf(fabsf(h.z), fabsf(h.w))); } else o8[64 * j] = (u32x2){pk2(h.x, h.y), pk2(h.z, h.w)};
            if (ROUTE) {
#pragma unroll
                for (int e = 0; e < 8; ++e) lg[e] += (h.x * wreg[j][e >> 2][e & 3] + h.y * wreg[j][2 + (e >> 2)][e & 3]) + (h.z * wreg[j][4 + (e >> 2)][e & 3] + h.w * wreg[j][6 + (e >> 2)][e & 3]); } }
        if (I8OUT) {
#pragma unroll
            for (int o = 1; o < 64; o <<= 1) amax = fmaxf(amax, __shfl_xor(amax, o));
            const float inv = amax > 0.f ? 127.f / amax : 0.f;
            if (C.lane == 0) ((float*)(C.ws + WS_META + MT_SH))[row] = amax * (1.f / 127.f);
#pragma unroll
            for (int j = 0; j < 4; ++j) { const int a = (int)rintf(hq[j].x * inv), b = (int)rintf(hq[j].y * inv), c = (int)rintf(hq[j].z * inv), d = (int)rintf(hq[j].w * inv);
                o4[64 * j] = (unsigned)(a & 255) | ((unsigned)(b & 255) << 8) | ((unsigned)(c & 255) << 16) | ((unsigned)(d & 255) << 24); } }
        if (ROUTE) {
#pragma unroll
            for (int e = 0; e < 8; ++e) lg[e] = wave_sum(lg[e]);
            int e1 = 0; float l1 = lg[0];
#pragma unroll
            for (int e = 1; e < 8; ++e) if (lg[e] > l1) { l1 = lg[e]; e1 = e; }
            int e2 = -1; float l2 = -3.0e38f;
#pragma unroll
            for (int e = 0; e < 8; ++e) if (e != e1 && lg[e] > l2) { l2 = lg[e]; e2 = e; }
            if (C.lane == 0) { const float w2 = 1.f / (1.f + expf(l1 - l2)), w1 = 1.f - w2; le[rr * 2] = e1; le[rr * 2 + 1] = e2; RE[row * 2] = e1; RE[row * 2 + 1] = e2; RW[row * 2] = w1; RW[row * 2 + 1] = w2; }
        }
    }
    if (ROUTE) {
        __syncthreads();
        LAS int* lr = le + 264;
        if (C.tid < 8) { int cnt = 0; for (int i = 0; i < chunk * 2; ++i) if (le[i] == C.tid) lr[i] = cnt++; BC[blockIdx.x * 8 + C.tid] = cnt; }
        __syncthreads();
        for (int i = C.tid; i < chunk * 2; i += 512) LR[row0 * 2 + i] = (le[i] >= 0) ? lr[i] : 0;
        __syncthreads();
    }
}
__device__ __forceinline__ void qkpost_phase(const Ctx& C, const float* qn, const float* kn, bool ctx_q) {
    const bf16_t* P = (const bf16_t*)(C.ws + WS_P); const bf16_t* QR = (const bf16_t*)(C.ws + WS_QRAW); const bf16_t* KVR = (const bf16_t*)(C.ws + WS_KVRAW);
    unsigned char* Q = C.ws + WS_Q; unsigned char* K = C.ws + WS_K; unsigned char* V = C.ws + WS_V;
    const int lane = C.lane, h = lane >> 3, s = lane & 7;
    const int rb1 = (s < 4) ? 64 : 80, i0 = (2 * s) & 7;
    float gq[12], gk[12];
#pragma unroll
    for (int j = 0; j < 8; ++j) { gq[j] = qn[8 * s + j]; gk[j] = kn[8 * s + j]; }
    gq[8] = qn[rb1 + i0]; gq[9] = qn[rb1 + i0 + 1]; gq[10] = qn[rb1 + 8 + i0]; gq[11] = qn[rb1 + 8 + i0 + 1];
    gk[8] = kn[rb1 + i0]; gk[9] = kn[rb1 + i0 + 1]; gk[10] = kn[rb1 + 8 + i0]; gk[11] = kn[rb1 + 8 + i0 + 1];
    const float if0 = powf(10000.f, -(float)i0 * 0.125f), if1 = powf(10000.f, -(float)(i0 + 1) * 0.125f);
    for (int grp = C.gw; grp < TT / 4; grp += C.NGW) {
      const int row0 = grp * 4, b = row0 / SB, j0 = row0 - b * SB; const bool isctx = j0 >= SEQ;
      float vprev[8]; int vacc[8];
#pragma unroll
      for (int i = 0; i < 8; ++i) { vprev[i] = 0.f; vacc[i] = 0; }
#pragma unroll
      for (int rr = 0; rr < 4; ++rr) {
        const int row = row0 + rr, j = j0 + rr;
        const bf16_t* pr = P + (size_t)row * INW;
        const u32x2 cq = *(const u32x2*)(pr + 4 * lane), ckv = *(const u32x2*)(pr + 256 + 4 * lane);
        float sq = bflo(cq.x) * bflo(cq.x) + bfhi(cq.x) * bfhi(cq.x) + bflo(cq.y) * bflo(cq.y) + bfhi(cq.y) * bfhi(cq.y);
        float sk = bflo(ckv.x) * bflo(ckv.x) + bfhi(ckv.x) * bfhi(ckv.x) + bflo(ckv.y) * bflo(ckv.y) + bfhi(ckv.y) * bfhi(ckv.y);
        const float aq = rsqrtf(wave_sum(sq) * (1.f / 256.f) + EPS), akv = rsqrtf(wave_sum(sk) * (1.f / 256.f) + EPS);
        float cs0 = 1.f, sn0 = 0.f, cs1 = 1.f, sn1 = 0.f;
        if (!isctx) { const float pos = (s < 4) ? (float)(j >> 6) : (float)(j & 63); sincosf(pos * if0, &sn0, &cs0); sincosf(pos * if1, &sn1, &cs1); }
        { const bf16_t* kvr = KVR + (size_t)row * 1024 + h * 128;
          const u32x4 kn8 = *(const u32x4*)(kvr + 8 * s), vv8 = *(const u32x4*)(kvr + 64 + 8 * s);
          const unsigned pe1 = *(const unsigned*)(pr + 512 + (rb1 - 64) + i0), pe2 = *(const unsigned*)(pr + 512 + (rb1 - 64) + 8 + i0);
          float x[12]; x[0] = bflo(kn8.x) * akv; x[1] = bfhi(kn8.x) * akv; x[2] = bflo(kn8.y) * akv; x[3] = bfhi(kn8.y) * akv; x[4] = bflo(kn8.z) * akv; x[5] = bfhi(kn8.z) * akv; x[6] = bflo(kn8.w) * akv; x[7] = bfhi(kn8.w) * akv;
          x[8] = bflo(pe1); x[9] = bfhi(pe1); x[10] = bflo(pe2); x[11] = bfhi(pe2);
          float ss = 0.f;
#pragma unroll
          for (int i = 0; i < 12; ++i) ss += x[i] * x[i];
          ss += __shfl_xor(ss, 1); ss += __shfl_xor(ss, 2); ss += __shfl_xor(ss, 4);
          const float rn = rsqrtf(ss * (1.f / 96.f) + EPS);
#pragma unroll
          for (int i = 0; i < 12; ++i) x[i] = x[i] * rn * gk[i];
          const float r0 = x[8] * cs0 - x[10] * sn0, r1 = x[9] * cs1 - x[11] * sn1, r2 = x[8] * sn0 + x[10] * cs0, r3 = x[9] * sn1 + x[11] * cs1;
          unsigned char* ko = K + (size_t)row * 768 + h * 96;
          *(u32x2*)(ko + 8 * s) = (u32x2){pk4f8(x[0], x[1], x[2], x[3]), pk4f8(x[4], x[5], x[6], x[7])};
          *(unsigned short*)(ko + rb1 + i0) = (unsigned short)pk4f8(r0, r1, 0.f, 0.f); *(unsigned short*)(ko + rb1 + 8 + i0) = (unsigned short)pk4f8(r2, r3, 0.f, 0.f);
          const float vf[8] = {c448(bflo(vv8.x) * akv), c448(bfhi(vv8.x) * akv), c448(bflo(vv8.y) * akv), c448(bfhi(vv8.y) * akv), c448(bflo(vv8.z) * akv), c448(bfhi(vv8.z) * akv), c448(bflo(vv8.w) * akv), c448(bfhi(vv8.w) * akv)};
#pragma unroll
          for (int i = 0; i < 8; ++i) { if (rr == 1) vacc[i] = __builtin_amdgcn_cvt_pk_fp8_f32(vprev[i], vf[i], vacc[i], false); else if (rr == 3) vacc[i] = __builtin_amdgcn_cvt_pk_fp8_f32(vprev[i], vf[i], vacc[i], true); else vprev[i] = vf[i]; } }
        if (!isctx || ctx_q) {
          const bf16_t* qr = QR + (size_t)row * 768 + h * 96;
          const u32x4 q8 = *(const u32x4*)(qr + 8 * s); const unsigned q1 = *(const unsigned*)(qr + rb1 + i0), q2 = *(const unsigned*)(qr + rb1 + 8 + i0);
          float x[12]; x[0] = bflo(q8.x); x[1] = bfhi(q8.x); x[2] = bflo(q8.y); x[3] = bfhi(q8.y); x[4] = bflo(q8.z); x[5] = bfhi(q8.z); x[6] = bflo(q8.w); x[7] = bfhi(q8.w);
          x[8] = bflo(q1); x[9] = bfhi(q1); x[10] = bflo(q2); x[11] = bfhi(q2);
          float ss = 0.f;
#pragma unroll
          for (int i = 0; i < 12; ++i) { x[i] *= aq; ss += x[i] * x[i]; }
          ss += __shfl_xor(ss, 1); ss += __shfl_xor(ss, 2); ss += __shfl_xor(ss, 4);
          const float rn = rsqrtf(ss * (1.f / 96.f) + EPS) * QSCALE;
#pragma unroll
          for (int i = 0; i < 12; ++i) x[i] = x[i] * rn * gq[i];
          const float r0 = x[8] * cs0 - x[10] * sn0, r1 = x[9] * cs1 - x[11] * sn1, r2 = x[8] * sn0 + x[10] * cs0, r3 = x[9] * sn1 + x[11] * cs1;
          unsigned char* qo = Q + (size_t)row * 768 + h * 96;
          *(u32x2*)(qo + 8 * s) = (u32x2){pk4f8(x[0], x[1], x[2], x[3]), pk4f8(x[4], x[5], x[6], x[7])};
          *(unsigned short*)(qo + rb1 + i0) = (unsigned short)pk4f8(r0, r1, 0.f, 0.f); *(unsigned short*)(qo + rb1 + 8 + i0) = (unsigned short)pk4f8(r2, r3, 0.f, 0.f); }
      }
      unsigned char* vo = V + ((size_t)(b * NH + h) * (SB / 64) + (j0 >> 6)) * 4096 + (8 * s) * 64 + (j0 & 63);
#pragma unroll
      for (int i = 0; i < 8; ++i) *(unsigned*)(vo + i * 64) = (unsigned)vacc[i];
    }
}
__device__ __forceinline__ void mixnorm_phase(const Ctx& C, const float* ga, const float* gf, bool with_ctx) {
    const bf16_t* AT = (const bf16_t*)(C.ws + WS_ATT); const bf16_t* FO = (const bf16_t*)(C.ws + WS_FOUR); signed char* H8 = (signed char*)(C.ws + WS_H); float* SH = (float*)(C.ws + WS_META + MT_SH);
    const int lane = C.lane;
    const f32x4 ga0 = *(const f32x4*)(ga + 8 * lane), ga1 = *(const f32x4*)(ga + 8 * lane + 4), gf0 = *(const f32x4*)(gf + 8 * lane), gf1 = *(const f32x4*)(gf + 8 * lane + 4);
    for (int row = C.gw; row < TT; row += C.NGW) {
        if (!with_ctx && (row % SB) >= SEQ) continue;
        const u32x4 a = *(const u32x4*)(AT + (size_t)row * 512 + 8 * lane), f = *(const u32x4*)(FO + (size_t)row * 512 + 8 * lane);
        float xa[8] = {bflo(a.x), bfhi(a.x), bflo(a.y), bfhi(a.y), bflo(a.z), bfhi(a.z), bflo(a.w), bfhi(a.w)}, xf[8] = {bflo(f.x), bfhi(f.x), bflo(f.y), bfhi(f.y), bflo(f.z), bfhi(f.z), bflo(f.w), bfhi(f.w)};
        float sa = 0.f, sf = 0.f;
#pragma unroll
        for (int i = 0; i < 8; ++i) { sa += xa[i] * xa[i]; sf += xf[i] * xf[i]; }
        const float ra = rsqrtf(wave_sum(sa) * (1.f / 512.f) + EPS), rf = rsqrtf(wave_sum(sf) * (1.f / 512.f) + EPS);
        float amax = 0.f;
#pragma unroll
        for (int i = 0; i < 4; ++i) { xa[i] = xa[i] * ra * ga0[i]; xa[4 + i] = xa[4 + i] * ra * ga1[i]; xf[i] = xf[i] * rf * gf0[i]; xf[4 + i] = xf[4 + i] * rf * gf1[i]; }
#pragma unroll
        for (int i = 0; i < 8; ++i) amax = fmaxf(amax, fmaxf(fabsf(xa[i]), fabsf(xf[i])));
#pragma unroll
        for (int o = 1; o < 64; o <<= 1) amax = fmaxf(amax, __shfl_xor(amax, o));
        const float inv = amax > 0.f ? 127.f / amax : 0.f;
        if (lane == 0) SH[row] = amax * (1.f / 127.f);
        unsigned qa[2], qf[2];
#pragma unroll
        for (int i = 0; i < 2; ++i) { qa[i] = ((unsigned)((int)rintf(xa[4 * i] * inv) & 255)) | ((unsigned)((int)rintf(xa[4 * i + 1] * inv) & 255) << 8) | ((unsigned)((int)rintf(xa[4 * i + 2] * inv) & 255) << 16) | ((unsigned)((int)rintf(xa[4 * i + 3] * inv) & 255) << 24);
            qf[i] = ((unsigned)((int)rintf(xf[4 * i] * inv) & 255)) | ((unsigned)((int)rintf(xf[4 * i + 1] * inv) & 255) << 8) | ((unsigned)((int)rintf(xf[4 * i + 2] * inv) & 255) << 16) | ((unsigned)((int)rintf(xf[4 * i + 3] * inv) & 255) << 24); }
        signed char* o = H8 + (size_t)row * DM + 8 * lane;
        *(u32x2*)o = (u32x2){qa[0], qa[1]}; *(u32x2*)(o + 512) = (u32x2){qf[0], qf[1]};
    }
}
__device__ __forceinline__ void moe_assign_phase(const Ctx& C) {
    const int* RE = (const int*)(C.ws + WS_META + MT_RE); const int* LR = (const int*)(C.ws + WS_META + MT_LR); const int* BC = (const int*)(C.ws + WS_META + MT_BC);
    int* TS = (int*)(C.ws + WS_META + MT_TS); int* TE = (int*)(C.ws + WS_META + MT_TE); int* NTP = (int*)(C.ws + WS_META + MT_NT);
    LAS int* bc = (LAS int*)C.lds; LAS int* base = bc + 2048;
    for (int i = C.tid; i < 2048; i += 512) bc[i] = BC[i];
    __syncthreads();
    if (C.tid < 8) { int pre = 0, tot = 0; for (int b = 0; b < 256; ++b) { const int v = bc[b * 8 + C.tid]; if (b < (int)blockIdx.x) pre += v; tot += v; } base[C.tid] = pre; base[8 + C.tid] = tot; }
    __syncthreads();
    if (C.tid == 0) { int run = 0; for (int e = 0; e < 8; ++e) { const int tot = base[8 + e], tiles = (tot + 255) >> 8;
            if (blockIdx.x == 0) for (int t = 0; t < tiles; ++t) TE[(run >> 8) + t] = e;
            base[e] += run; run += tiles << 8; }
        if (blockIdx.x == 0) NTP[0] = run >> 8; }
    __syncthreads();
    const bf16_t* H = (const bf16_t*)(C.ws + WS_H); bf16_t* AM = (bf16_t*)(C.ws + WS_AMOE);
    const int chunk = TT / 256, row0 = blockIdx.x * chunk;
    for (int rr = C.wave; rr < chunk; rr += 8) { const int row = row0 + rr;
#pragma unroll
        for (int k = 0; k < 2; ++k) { const int e = RE[row * 2 + k]; if (e < 0) { if (C.lane == 0) TS[row * 2 + k] = -1; continue; }
            const int slot = base[e] + LR[row * 2 + k]; if (C.lane == 0) TS[row * 2 + k] = slot;
            const u32x4* src = (const u32x4*)((const signed char*)H + (size_t)row * DM) + C.lane; u32x4* dst = (u32x4*)((signed char*)AM + (size_t)slot * DM) + C.lane;
            dst[0] = src[0]; if (C.lane == 0) ((float*)(C.ws + WS_META + MT_SA))[slot] = ((const float*)(C.ws + WS_META + MT_SH))[row]; } }
}
template <bool FUSE_N1, bool DST_F32> __device__ __forceinline__ void moe_combine_phase(const Ctx& C, bf16_t* lat, bf16_t* ctx, float* out32, const float* modl, int gate_off, const float* gain_n = nullptr, const float* modn = nullptr) {
    const int* TS = (const int*)(C.ws + WS_META + MT_TS); const float* RW = (const float*)(C.ws + WS_META + MT_RW); const bf16_t* Y = (const bf16_t*)(C.ws + WS_Y);
    for (int row = C.gw; row < TT; row += C.NGW) {
        const int s0 = TS[row * 2], s1 = TS[row * 2 + 1]; if (s0 < 0) continue;
        int mr; bool isctx; const size_t ro = res_row_off(row, mr, isctx); bf16_t* xr = (isctx ? ctx : lat) + ro;
        const float w0 = RW[row * 2] * DOWN_OSCALE, w1 = RW[row * 2 + 1] * DOWN_OSCALE;
        const f32x4* gv = (const f32x4*)(modl + (size_t)mr * 6144 + gate_off) + C.lane;
        const u32x2* y0 = (const u32x2*)(Y + (size_t)s0 * DM) + C.lane; const u32x2* y1 = (const u32x2*)(Y + (size_t)s1 * DM) + C.lane;
        f32x4 xs[4]; float ss = 0.f;
#pragma unroll
        for (int j = 0; j < 4; ++j) { const u32x2 a = y0[64 * j], b = y1[64 * j]; const f32x4 g = gv[64 * j]; f32x4 x = ld4<false>(xr, C.lane + 64 * j);
            x.x += g.x * (w0 * bflo(a.x) + w1 * bflo(b.x)); x.y += g.y * (w0 * bfhi(a.x) + w1 * bfhi(b.x)); x.z += g.z * (w0 * bflo(a.y) + w1 * bflo(b.y)); x.w += g.w * (w0 * bfhi(a.y) + w1 * bfhi(b.y));
            if constexpr (DST_F32) st4<true>(out32 + ro, C.lane + 64 * j, x); else st4<false>(xr, C.lane + 64 * j, x);
            xs[j] = x; ss += (x.x * x.x + x.y * x.y) + (x.z * x.z + x.w * x.w); }
        if constexpr (FUSE_N1) {
            const float rinv = rsqrtf(wave_sum(ss) * (1.f / DM) + EPS);
            const f32x4* gn = (const f32x4*)gain_n + C.lane; const f32x4* shv = (const f32x4*)(modn + (size_t)mr * 6144) + C.lane; const f32x4* scv = (const f32x4*)(modn + (size_t)mr * 6144 + 1024) + C.lane;
            float amax = 0.f;
#pragma unroll
            for (int j = 0; j < 4; ++j) { const f32x4 h = ((xs[j] * rinv) * gn[64 * j]) * (scv[64 * j] + 1.f) + shv[64 * j]; xs[j] = h; amax = fmaxf(fmaxf(amax, fmaxf(fabsf(h.x), fabsf(h.y))), fmaxf(fabsf(h.z), fabsf(h.w))); }
#pragma unroll
            for (int o = 1; o < 64; o <<= 1) amax = fmaxf(amax, __shfl_xor(amax, o));
            const float inv = amax > 0.f ? 127.f / amax : 0.f;
            if (C.lane == 0) ((float*)(C.ws + WS_META + MT_SH))[row] = amax * (1.f / 127.f);
            unsigned* o4 = (unsigned*)((signed char*)(C.ws + WS_H) + (size_t)row * DM) + C.lane;
#pragma unroll
            for (int j = 0; j < 4; ++j) { const int a = (int)rintf(xs[j].x * inv), b = (int)rintf(xs[j].y * inv), c = (int)rintf(xs[j].z * inv), d = (int)rintf(xs[j].w * inv);
                o4[64 * j] = (unsigned)(a & 255) | ((unsigned)(b & 255) << 8) | ((unsigned)(c & 255) << 16) | ((unsigned)(d & 255) << 24); } }
    }
}
#ifndef R_ATT
#define R_ATT 1
#endif
#ifndef R_MOE
#define R_MOE 1
#endif
#ifndef R_PROJ
#define R_PROJ 1
#endif
#ifndef R_GU
#define R_GU 1
#endif
#ifndef R_BAR
#define R_BAR 1
#endif
#ifndef R_N1
#define R_N1 1
#endif
#ifndef R_F1
#define R_F1 1
#endif
#ifndef R_QK
#define R_QK 1
#endif
#ifndef R_F2
#define R_F2 1
#endif
#ifndef R_MX
#define R_MX 1
#endif
#ifndef R_CF
#define R_CF 1
#endif
#ifndef R_CMB
#define R_CMB 1
#endif
#ifndef R_MISC
#define R_MISC 1
#endif
#ifndef R_PRO
#define R_PRO 1
#endif
#ifndef R_N2
#define R_N2 1
#endif
#ifndef R_ASG
#define R_ASG 1
#endif
#ifndef R_CV3
#define R_CV3 1
#endif

#define GRID_BAR() do { XcdBarrier b_; b_.bar = (unsigned*)(KA()->ws + WS_CTL); b_.x = xb_xcc_id(); b_.st = (volatile LAS unsigned*)(lds + MISC_OFF) + 8; for (int rb_ = 0; rb_ < R_BAR; ++rb_) xcd_barrier(b_); } while (0)
#define PHASE_CTX() Ctx C; { KArgs* ka_ = KA(); C.out = ka_->out; C.ws = ka_->ws; C.lds = lds; C.tid = otid(); C.lane = C.tid & 63; C.wave = __builtin_amdgcn_readfirstlane(C.tid >> 6); \
        C.G = gridDim.x; const int bx_ = blockIdx.x; C.vcu = (C.G % 8 == 0) ? (bx_ % 8) * (C.G / 8) + bx_ / 8 : bx_; C.gw = C.vcu * 8 + C.wave; C.NGW = C.G * 8; } \
        unsigned char* ws = C.ws; float* mod = (float*)(ws + WS_MOD); bf16_t* ctxs = (bf16_t*)(ws + WS_XCB); bf16_t* xb = (bf16_t*)(ws + WS_XB); bf16_t* H = (bf16_t*)(ws + WS_H); bf16_t* P = (bf16_t*)(ws + WS_P); const int G = C.G, bx = blockIdx.x; \
        const float* modl = mod + (size_t)l * 5 * 6144; const void* lat_res = (l == 0) ? (const void*)KA()->in[I_X] : (const void*)xb; const void* ctx_res = (l == 0) ? (const void*)KA()->in[I_CTX] : (const void*)ctxs; \
        (void)mod; (void)ctxs; (void)xb; (void)H; (void)P; (void)G; (void)bx; (void)modl; (void)lat_res; (void)ctx_res;
template <int l> __device__ __forceinline__ void layer_body(LAS unsigned char* lds) {
        const bool upd = l < DEPTH - 1;
        if (l != 2) {
        for (int rep_ = 0; rep_ < R_N1; ++rep_) { PHASE_CTX(); norm_phase<false, true, l == 0>(C, lat_res, ctx_res, KA()->in[I_NORM1] + l * DM, modl, 0, 1024, true, nullptr, (l == 0 || (l & 1)) ? ctxs : nullptr, (l & 1) ? 3 : 0); }
        GRID_BAR();
        }
        for (int rep_ = 0; rep_ < R_PROJ; ++rep_) { PHASE_CTX(); pg8::DenseOrder S{(const char*)H, (const char*)(ws + WS_WIN) + (size_t)l * 1280 * DM, (size_t)256 * DM, (size_t)256 * DM, MT, 5, G, bx, 0};
          pg8::EpiBf16<1> E{P, (const float*)(ws + WS_META + MT_SH), (const float*)(ws + WS_SCL + SCL_SWI) + l * 1280, INW, INW};
          pg8::gemm_phase<pg8::EpiBf16<1>, pg8::DenseOrder, true, true>(lds, DM / 2, DM / 2, DM / 2, S, E); }
        GRID_BAR();
        for (int rep_ = 0; rep_ < R_PROJ; ++rep_) { PHASE_CTX(); pg8::DenseOrder S{(const char*)P, (const char*)((bf16_t*)(ws + WS_WUQ) + (size_t)l * 768 * 256), (size_t)256 * INW * 2, (size_t)256 * 256 * 2, MT, 3, G, bx, 0};
          pg8::EpiBf16<0> E{(bf16_t*)(ws + WS_QRAW), nullptr, nullptr, 768, 768};
          int kk_ = 256; asm volatile("" : "+s"(kk_));
          pg8::gemm_phase<pg8::EpiBf16<0>, pg8::DenseOrder, true, true>(lds, kk_, INW, 256, S, E); }
        for (int rep_ = 0; rep_ < R_PROJ; ++rep_) { PHASE_CTX(); pg8::DenseOrder S{(const char*)(P + 256), (const char*)((bf16_t*)(ws + WS_WUKV) + (size_t)l * 1024 * 256), (size_t)256 * INW * 2, (size_t)256 * 256 * 2, MT, 4, G, (bx + G - 144) % G, 0};
          pg8::EpiBf16<0> E{(bf16_t*)(ws + WS_KVRAW), nullptr, nullptr, 1024, 1024};
          int kk_ = 256; asm volatile("" : "+s"(kk_));
          pg8::gemm_phase<pg8::EpiBf16<0>, pg8::DenseOrder, true, true>(lds, kk_, INW, 256, S, E); }
        for (int rep_ = 0; rep_ < R_F1; ++rep_) { PHASE_CTX(); fft::fft1_phase(P, (bf16_t*)(ws + WS_MID), lds, C.vcu, G); }
        if (upd) for (int rep_ = 0; rep_ < R_CF; ++rep_) { PHASE_CTX(); fft::ctxfour_phase(P, (bf16_t*)(ws + WS_FOUR), lds, C.vcu, G); }
        GRID_BAR();
        for (int rep_ = 0; rep_ < R_QK; ++rep_) { PHASE_CTX(); qkpost_phase(C, KA()->in[I_QN] + l * QKD, KA()->in[I_KN] + l * QKD, upd); }
        for (int rep_ = 0; rep_ < R_F2; ++rep_) { PHASE_CTX(); fft::fft2_phase((const bf16_t*)(ws + WS_MID), (bf16_t*)(ws + WS_FOUR), lds, C.vcu, G); }
        GRID_BAR();
        for (int rep_ = 0; rep_ < R_ATT; ++rep_) { PHASE_CTX(); const unsigned char* Q = ws + WS_Q; const unsigned char* K = ws + WS_K; const unsigned char* V = ws + WS_V; bf16_t* AT = (bf16_t*)(ws + WS_ATT);
          for (int U = C.vcu; U < 512; U += G) { const int i = U >> 8, v = U & 255, bh = v >> 3, qb = (v & 7) + 8 * i, b = bh >> 3, h = bh & 7;
              att::attn_unit(Q + ((size_t)b * SB + qb * 512) * 768 + h * 96, K + (size_t)b * SB * 768 + h * 96, V + (size_t)bh * (SB / 64) * 4096, AT + ((size_t)b * SB + qb * 512) * 512 + h * 64, SB / 64, 8, lds); }
          if (upd) for (int U = C.vcu; U < 256; U += G) { if (U & 7) continue; const int bh = U >> 3, b = bh >> 3, h = bh & 7; const size_t r0 = (size_t)b * SB + SEQ;
              att::attn_unit(Q + r0 * 768 + h * 96, K + r0 * 768 + h * 96, V + ((size_t)bh * (SB / 64) + SEQ / 64) * 4096, AT + r0 * 512 + h * 64, CTXL / 64, 4, lds); } }
        GRID_BAR();
        for (int rep_ = 0; rep_ < R_MX; ++rep_) { PHASE_CTX(); mixnorm_phase(C, KA()->in[I_ONA] + l * AW, KA()->in[I_ONF] + l * FW, upd); }
        GRID_BAR();
        { PHASE_CTX(); pg8::DenseOrder S{(const char*)H, (const char*)(ws + WS_WOUT) + (size_t)l * DM * DM, (size_t)256 * DM, (size_t)256 * DM, 128, 4, G, bx, 1};
          pg8::EpiResid<1, l == 0> E{lat_res, xb, ctx_res, ctxs, modl + 2048, (const float*)(ws + WS_META + MT_SH), (const float*)(ws + WS_SCL + SCL_SWO) + l * DM, 1.f / 127.f};
          pg8::gemm_phase<pg8::EpiResid<1, l == 0>, pg8::DenseOrder, true, true>(lds, DM / 2, DM / 2, DM / 2, S, E); }
#define CTX_WOUT(kp) { PHASE_CTX();       \
          pg8::CtxOrder S{(const char*)H + (kp) * 512, (const char*)(ws + WS_WOUT) + (size_t)l * DM * DM + (kp) * 512, (size_t)256 * DM, (size_t)256 * DM, G, (bx + G - 16 * (kp)) % G}; \
          pg8::EpiCtxPart<1> E{(float*)(ws + WS_CPART) + (size_t)(kp) * NB * CTXL * DM, modl + 2048, (const float*)(ws + WS_META + MT_SH), (const float*)(ws + WS_SCL + SCL_SWO) + l * DM, 1.f / 127.f, 0}; \
          int kk_ = 256; asm volatile("" : "+s"(kk_));     \
          pg8::gemm_phase<pg8::EpiCtxPart<1>, pg8::CtxOrder, true, true>(lds, kk_, DM / 2, DM / 2, S, E); }
        if (upd) { CTX_WOUT(0) CTX_WOUT(1) }
#undef CTX_WOUT
        GRID_BAR();
        if ((l & 1) == 0) {
            for (int rep_ = 0; rep_ < R_N2; ++rep_) { PHASE_CTX(); norm_phase<false, true, false>(C, xb, ctxs, KA()->in[I_NORM2] + l * DM, modl, 3072, 4096, upd, nullptr, upd ? ctxs : nullptr, 2); }
            GRID_BAR();
            for (int rep_ = 0; rep_ < R_GU; ++rep_) { PHASE_CTX(); pg8::DenseOrder S{(const char*)H, (const char*)(ws + WS_WGU) + (size_t)(l >> 1) * 5632 * DM, (size_t)256 * DM, (size_t)256 * DM, upd ? MT : 128, 22, G, bx, upd ? 0 : 1};
              pg8::EpiSwigluI8<true> E{(bf16_t*)(ws + WS_HID), FFN, (const float*)(ws + WS_META + MT_SH), (const float*)(ws + WS_SCL + SCL_SWD) + (l >> 1) * 5632, lds};
              pg8::gemm_phase<pg8::EpiSwigluI8<true>, pg8::DenseOrder, true, true>(lds, DM / 2, DM / 2, DM / 2, S, E); }
#ifdef R_GUX
            { PHASE_CTX(); pg8::DenseOrder S{(const char*)H, (const char*)(ws + WS_WGU) + (size_t)(l >> 1) * 5632 * DM, (size_t)256 * DM, (size_t)256 * DM, upd ? MT : 128, 22, G, bx, upd ? 0 : 1};
#if R_GUX == 0
              pg8::EpiSwigluI8<true> E{(bf16_t*)(ws + WS_Y), FFN, (const float*)(ws + WS_META + MT_SH), (const float*)(ws + WS_SCL + SCL_SWD) + (l >> 1) * 5632, lds};
              pg8::gemm_phase<pg8::EpiSwigluI8<true>, pg8::DenseOrder, true, true>(lds, DM / 2, DM / 2, DM / 2, S, E); }
#else
              pg8::EpiNullI8 E{(unsigned*)(ws + WS_Y)};
              pg8::gemm_phase<pg8::EpiNullI8, pg8::DenseOrder, true, true>(lds, DM / 2, DM / 2, DM / 2, S, E); }
#endif
#endif
            GRID_BAR();
            { PHASE_CTX(); pg8::DenseOrder S{(const char*)(ws + WS_HID), (const char*)(ws + WS_WD) + (size_t)(l >> 1) * DM * FFN, (size_t)256 * FFN, (size_t)256 * FFN, 128, 4, G, bx, 1};
              pg8::EpiResid<2, false> E{xb, xb, ctxs, ctxs, modl + 5120, nullptr, nullptr, DOWN_OSCALE};
              pg8::gemm_phase<pg8::EpiResid<2, false>, pg8::DenseOrder, true, true>(lds, FFN / 2, FFN / 2, FFN / 2, S, E); }
#define CTX_DOWN(kp) { PHASE_CTX();     \
              const int kb = (kp) * 1024, kk = ((kp) < 2) ? 512 : 384; \
              pg8::CtxOrder S{(const char*)(ws + WS_HID) + kb, (const char*)(ws + WS_WD) + (size_t)(l >> 1) * DM * FFN + kb, (size_t)256 * FFN, (size_t)256 * FFN, G, (bx + G - 16 * (kp)) % G}; \
              pg8::EpiCtxPart<2> E{(float*)(ws + WS_CPART) + (size_t)(kp) * NB * CTXL * DM, modl + 5120, nullptr, nullptr, DOWN_OSCALE, 0}; \
              pg8::gemm_phase<pg8::EpiCtxPart<2>, pg8::CtxOrder, true, true>(lds, kk, FFN / 2, FFN / 2, S, E); }
            if (upd) { CTX_DOWN(0) CTX_DOWN(1) CTX_DOWN(2) }
#undef CTX_DOWN
            GRID_BAR();
        } else {
            for (int rep_ = 0; rep_ < R_N2; ++rep_) { PHASE_CTX(); norm_phase<true, true, false>(C, xb, ctxs, KA()->in[I_NORM2] + l * DM, modl, 3072, 4096, upd, KA()->in[I_WR] + (size_t)(l >> 1) * DM * NE, upd ? ctxs : nullptr, 2); }
            GRID_BAR();
            for (int rep_ = 0; rep_ < R_ASG; ++rep_) { PHASE_CTX(); moe_assign_phase(C); }
            GRID_BAR();
            for (int rep_ = 0; rep_ < R_MOE; ++rep_) {
                { PHASE_CTX(); const int ntiles = __builtin_amdgcn_readfirstlane(*(const int*)(ws + WS_META + MT_NT)); LAS int* TE = (LAS int*)(lds + MISC_OFF + 8192);
                  if (C.tid < MOE_MAX_TILES) TE[C.tid] = ((const int*)(ws + WS_META + MT_TE))[C.tid]; __syncthreads();
                  pg8::MoeOrder S{(const char*)(ws + WS_AMOE), (const char*)(ws + WS_MGU), (size_t)256 * DM, (size_t)256 * DM, (size_t)7168 * DM, TE, 0, ntiles, 28, G, bx, 7168};
                  pg8::EpiSwigluI8<true> E{(bf16_t*)(ws + WS_HMOE), MFF, (const float*)(ws + WS_META + MT_SA), (const float*)(ws + WS_SCL + SCL_SWM) + (size_t)(l >> 1) * 8 * 7168, lds};
                  pg8::gemm_phase<pg8::EpiSwigluI8<true>, pg8::MoeOrder, true, true>(lds, DM / 2, DM / 2, DM / 2, S, E); }
                GRID_BAR();
                { PHASE_CTX(); const int ntiles = __builtin_amdgcn_readfirstlane(*(const int*)(ws + WS_META + MT_NT)); LAS int* TE = (LAS int*)(lds + MISC_OFF + 8192);
                  if (C.tid < MOE_MAX_TILES) TE[C.tid] = ((const int*)(ws + WS_META + MT_TE))[C.tid]; __syncthreads();
                  pg8::MoeOrder S{(const char*)(ws + WS_HMOE), (const char*)(ws + WS_MD), (size_t)256 * MFF, (size_t)256 * MFF, (size_t)DM * MFF, TE, 0, ntiles, 4, G, bx, 0};
                  pg8::EpiBf16<2> E{(bf16_t*)(ws + WS_Y), nullptr, nullptr, DM, DM};
                  pg8::gemm_phase<pg8::EpiBf16<2>, pg8::MoeOrder, true, true>(lds, MFF / 2, MFF / 2, MFF / 2, S, E); }
                GRID_BAR();
            }
            { PHASE_CTX();
              if (l == 1) { moe_combine_phase<true, false>(C, xb, ctxs, nullptr, modl, 5120, KA()->in[I_NORM1] + (l + 1) * DM, mod + (size_t)(l + 1) * 5 * 6144); conv_moe(C, 1); }
              else moe_combine_phase<false, true>(C, xb, ctxs, C.out, modl, 5120); }
            GRID_BAR();
        }
}

__global__ void __launch_bounds__(512, 2) fwd_kernel(Args args) {
    extern __shared__ __attribute__((aligned(16))) unsigned char lds_raw[];
    LAS unsigned char* lds = (LAS unsigned char*)lds_raw;
    volatile LAS unsigned* MISC = (volatile LAS unsigned*)(lds + MISC_OFF);
    if (threadIdx.x < 32) MISC[threadIdx.x] = 0u;
    __syncthreads();
    (void)xcd_barrier_post((unsigned*)(args.ws + WS_CTL), MISC + 8);

    { const int l = 0; PHASE_CTX(); ada_phase(C); conv_dense_weights(C); conv_gu(C); conv_moe(C, 0); }
    GRID_BAR();

    layer_body<0>(lds); layer_body<1>(lds); layer_body<2>(lds); layer_body<3>(lds);
}

extern "C" void kernel_launch(void* const* d_in, const int* in_sizes, int n_in, void* d_out, int out_size, void* d_ws, size_t ws_size, hipStream_t stream) {
    static int grid = 0;
    if (grid == 0) {
        if (n_in != 25 || out_size != NB * SEQ * DM || ws_size < WS_END) { fprintf(stderr, "kernel_launch: unexpected shapes (n_in %d, out %d, ws %zu < %zu)\n", n_in, out_size, ws_size, (size_t)WS_END); grid = -1; return; }
        int dev = 0, cus = 0, per_cu = 0;
        if (hipGetDevice(&dev) != hipSuccess || hipDeviceGetAttribute(&cus, hipDeviceAttributeMultiprocessorCount, dev) != hipSuccess) { grid = -1; return; }
        if (hipFuncSetAttribute((const void*)fwd_kernel, hipFuncAttributeMaxDynamicSharedMemorySize, LDS_BYTES) != hipSuccess) { fprintf(stderr, "kernel_launch: hipFuncSetAttribute failed\n"); grid = -1; return; }
        if (hipOccupancyMaxActiveBlocksPerMultiprocessor(&per_cu, (const void*)fwd_kernel, 512, LDS_BYTES) != hipSuccess || per_cu < 1) { fprintf(stderr, "kernel_launch: occupancy query says %d\n", per_cu); }
        (void)hipGetLastError();
        grid = (cus >= 256) ? 256 : -1;
        if (grid < 0) fprintf(stderr, "kernel_launch: needs a 256-CU device (got %d)\n", cus);
    }
    if (grid < 0) return;
    if (hipMemsetAsync((char*)d_ws + WS_CTL, 0, CTL_ZERO_BYTES, stream) != hipSuccess) return;
    Args a{};
    for (int i = 0; i < 25; ++i) a.in[i] = (const float*)d_in[i];
    a.out = (float*)d_out; a.ws = (unsigned char*)d_ws; a.pad0 = 0; a.pad1 = 0;
    hipLaunchKernelGGL(fwd_kernel, dim3(grid), dim3(512), LDS_BYTES, stream, a);
}
```

```cpp
#include <hip/hip_runtime.h>
#include <cstdio>
#include <cstdint>

#define GAS __attribute__((address_space(1)))
#define LAS __attribute__((address_space(3)))
typedef unsigned short bf16_t;
typedef short bf16x8 __attribute__((ext_vector_type(8)));
typedef short s16x4 __attribute__((ext_vector_type(4)));
typedef float f32x2 __attribute__((ext_vector_type(2)));
typedef float f32x4 __attribute__((ext_vector_type(4)));
typedef float f32x16 __attribute__((ext_vector_type(16)));
typedef unsigned u32x2 __attribute__((ext_vector_type(2)));
typedef unsigned u32x4 __attribute__((ext_vector_type(4)));

constexpr int NB = 4, SEQ = 8192, CTXL = 256, SB = SEQ + CTXL, TT = NB * SB;
constexpr int DM = 1024, INW = 1056, NH = 8, QKD = 96, VD = 64, AW = 512, FW = 512;
constexpr int FFN = 2816, NE = 8, MFF = 3584, DEPTH = 4;
constexpr int MT = TT / 256;
constexpr float EPS = 1e-6f;
constexpr float QSCALE = 0.10206207261596577f * 1.4426950408889634f;

constexpr size_t MiB = 1u << 20;
constexpr size_t WS_CTL = 0, CTL_ZERO_BYTES = 16384;
constexpr size_t WS_MOD = 1 * MiB;
constexpr size_t WS_META = 2 * MiB;
constexpr size_t WS_CTXS = 4 * MiB;
constexpr size_t WS_SCL = 8 * MiB, SCL_ZERO_BYTES = 576 * 1024;
constexpr size_t SCL_SWM = 0, SCL_SWD = 2 * 8 * 7168 * 4, SCL_SWO = SCL_SWD + 2 * 5632 * 4, SCL_SWI = SCL_SWO + 4 * 1024 * 4;
constexpr size_t SCL_END = SCL_SWI + 4 * 1280 * 4;
static_assert(SCL_END <= SCL_ZERO_BYTES, "scale map");
constexpr size_t WS_WIN = 16 * MiB;
constexpr size_t WS_WUQ = 26 * MiB;
constexpr size_t WS_WUKV = 28 * MiB;
constexpr size_t WS_WOUT = 30 * MiB;
constexpr size_t WS_WGU = 38 * MiB;
constexpr size_t WS_WD = 60 * MiB;
constexpr size_t WS_MGU = 72 * MiB;
constexpr size_t WS_MD = 184 * MiB;
constexpr size_t WS_H = 240 * MiB;
constexpr size_t WS_R = 306 * MiB;
constexpr size_t WS_P = WS_R;
constexpr size_t WS_QRAW = WS_R + 69 * MiB;
constexpr size_t WS_KVRAW = WS_R + 119 * MiB;
constexpr size_t WS_Q = WS_R + 185 * MiB;
constexpr size_t WS_K = WS_R + 235 * MiB;
constexpr size_t WS_V = WS_R + 285 * MiB;
constexpr size_t WS_ATT = WS_R + 318 * MiB;
constexpr size_t WS_FOUR = WS_R + 351 * MiB;
constexpr size_t WS_MID = WS_R + 384 * MiB;
constexpr size_t WS_HID = WS_R;
constexpr size_t WS_AMOE = WS_R;
constexpr size_t WS_HMOE = WS_R + 68 * MiB;
constexpr size_t WS_Y = WS_R + 306 * MiB;
constexpr size_t WS_CPART = WS_R + 448 * MiB;
constexpr size_t WS_XB = WS_R + 496 * MiB;
constexpr size_t WS_XCB = WS_XB + 64 * MiB;
constexpr size_t WS_END = WS_XCB + 2 * MiB;
static_assert((size_t)TT * INW * 2 <= 69 * MiB && (size_t)TT * 768 * 2 <= 50 * MiB && (size_t)TT * 1024 * 2 <= 66 * MiB && (size_t)TT * 512 * 2 <= 33 * MiB, "activation sizes");
static_assert(WS_MID + 64 * MiB <= WS_END && (size_t)TT * FFN * 2 <= 182 * MiB, "map");
constexpr size_t MT_RE = 0, MT_RW = 270336 * 1, MT_LR = 270336 * 2, MT_TS = 270336 * 3, MT_BC = 270336 * 4, MT_TE = MT_BC + 8192, MT_NT = MT_TE + 2048;
constexpr size_t MT_SA = 1310720, MT_SWM = 1605632, MT_SH = 1835008, MT_SWD = 1970176;
static_assert(MT_NT + 64 <= MT_SA && MT_SA + 69632 * 4 <= MT_SWM && MT_SWM + 8 * 7168 * 4 <= MT_SH && MT_SH + TT * 4 <= MT_SWD && MT_SWD + 2 * 5632 * 4 <= 2 * MiB, "meta map");
constexpr int MOE_ROWS_MAX = 69632, MOE_MAX_TILES = 272;
static_assert(WS_HMOE + (size_t)MOE_ROWS_MAX * MFF <= WS_Y && WS_Y + (size_t)MOE_ROWS_MAX * DM * 2 <= WS_END, "moe map");
constexpr float HID_SCALE = 8.f, WD_SCALE = 64.f, DOWN_OSCALE = 1.f / 512.f;

constexpr int RING_BYTES = 131072, MISC_OFF = RING_BYTES, LDS_BYTES = 147456;

__device__ __forceinline__ unsigned cvt_pk_bf16(float lo, float hi) { unsigned r; asm volatile("v_cvt_pk_bf16_f32 %0, %1, %2" : "=v"(r) : "v"(lo), "v"(hi)); return r; }
__device__ __forceinline__ float bflo(unsigned u) { return __uint_as_float(u << 16); }
__device__ __forceinline__ float bfhi(unsigned u) { return __uint_as_float(u & 0xffff0000u); }
__device__ __forceinline__ float wave_sum(float v) {
#pragma unroll
    for (int o = 1; o < 64; o <<= 1) v += __shfl_xor(v, o);
    return v;
}
#define LDS_WAIT() asm volatile("s_waitcnt lgkmcnt(0)" ::: "memory")
#define VM_WAIT() asm volatile("s_waitcnt vmcnt(0)" ::: "memory")
__device__ __forceinline__ int otid() { int t = threadIdx.x; asm volatile("" : "+v"(t)); return t; }
namespace pg8 {
#define PG8_LAS __attribute__((address_space(3)))
#ifndef T_WGM
#define T_WGM 8
#endif
#ifndef T_XCD
#define T_XCD 1
#endif
constexpr int BM = 256, BK = 64, HALF = 128, HTB = HALF * BK * 2  , STAGE_BYTES = 8 * HTB, NXCD = 8, WGM = T_WGM;
__host__ __device__ __forceinline__ int lds_byte(int r, int c) { const int st = (r >> 4) * 2 + (c >> 5), rr = r & 15, cc = c & 31, ob = rr * 64 + cc * 2; return st * 1024 + (ob ^ (((ob >> 9) & 1) << 5)); }
__host__ __device__ __forceinline__ void stage_rc(int b, int& R, int& C) { const int st = b / 1024, sb = b % 1024, swz = sb ^ (((sb >> 9) & 1) << 5); R = (st >> 1) * 16 + swz / 64; C = (st & 1) * 32 + (swz % 64) / 2; }
__host__ __device__ __forceinline__ int perm32(int rho) { const int n = rho >> 4, i = rho & 15; return 8 * (i >> 2) + 4 * n + (i & 3); }

typedef int i32x4 __attribute__((ext_vector_type(4)));
typedef int i32x8 __attribute__((ext_vector_type(8)));
template <int MODE> struct AccOf { typedef f32x4 T; };
template <> struct AccOf<1> { typedef i32x4 T; };
template <int MODE> __device__ __forceinline__ typename AccOf<MODE>::T mma16(bf16x8 a, bf16x8 b, typename AccOf<MODE>::T c) {
    if constexpr (MODE == 1) return __builtin_amdgcn_mfma_i32_16x16x64_i8(__builtin_bit_cast(i32x4, a), __builtin_bit_cast(i32x4, b), c, 0, 0, 0);
    else return __builtin_amdgcn_mfma_f32_16x16x32_bf16(a, b, c, 0, 0, 0);
}
__device__ __forceinline__ f32x4 mma_f8(bf16x8 a0, bf16x8 a1, bf16x8 b0, bf16x8 b1, f32x4 c) {
    const i32x4 x0 = __builtin_bit_cast(i32x4, a0), x1 = __builtin_bit_cast(i32x4, a1), y0 = __builtin_bit_cast(i32x4, b0), y1 = __builtin_bit_cast(i32x4, b1);
    const i32x8 A = {x0[0], x0[1], x0[2], x0[3], x1[0], x1[1], x1[2], x1[3]}, B = {y0[0], y0[1], y0[2], y0[3], y1[0], y1[1], y1[2], y1[3]};
    return __builtin_amdgcn_mfma_scale_f32_16x16x128_f8f6f4(A, B, c, 0, 0, 0, 0x7F7F7F7F, 0, 0x7F7F7F7F);
}
__device__ __forceinline__ i32x8 cat8(bf16x8 lo, bf16x8 hi) { const i32x4 a = __builtin_bit_cast(i32x4, lo), b = __builtin_bit_cast(i32x4, hi); return __builtin_shufflevector(a, b, 0, 1, 2, 3, 4, 5, 6, 7); }
struct Unit { const char* A; const char* B; int pm, pn, B_scale_off, par; };

__device__ __forceinline__ bool tile_order(int i, int G, int c, int nM, int nN, int& tm, int& tn) {
    const int nwg = nM * nN; const long L = (long)i * G + c; if (L >= nwg) return false;
    int wgid = (int)L; if (T_XCD) { const int q = nwg / NXCD, r = nwg % NXCD, xcd = wgid % NXCD, off = wgid / NXCD; wgid = (xcd < r ? xcd * (q + 1) : r * (q + 1) + (xcd - r) * q) + off; }
    const int nig = WGM * nN, gid = wgid / nig, fm = gid * WGM, gsz = (nM - fm) < WGM ? (nM - fm) : WGM;
    tm = fm + ((wgid % nig) % gsz); tn = (wgid % nig) / gsz; return true;
}
struct DenseOrder {
    const char* A; const char* B; size_t a_tile_bytes, b_tile_bytes; int nM, nN, G, c, skipctx;
    __device__ __forceinline__ bool next(int i, Unit& u) const {
        int tm, tn; if (!tile_order(i, G, c, nM, nN, tm, tn)) return false;
        const int pm = skipctx ? tm + (tm >> 5) : tm; u.pm = pm; u.pn = tn; u.B_scale_off = 0; u.A = A + (size_t)pm * a_tile_bytes; u.B = B + (size_t)tn * b_tile_bytes; return true;
    }
};
struct CtxOrder {
    const char* A; const char* B; size_t a_tile_bytes, b_tile_bytes; int G, c;
    __device__ __forceinline__ bool next(int i, Unit& u) const {
        const int L = i * G + c; if (L >= 16) return false;
        const int pm = (L >> 2) * 33 + 32; u.pm = pm; u.pn = L & 3; u.B_scale_off = 0; u.A = A + (size_t)pm * a_tile_bytes; u.B = B + (size_t)(L & 3) * b_tile_bytes; return true;
    }
};
struct MoeOrder {
    const char* A; const char* B; size_t a_tile_bytes, b_tile_bytes, b_exp_bytes; const PG8_LAS int* tile_exp; int tile0, nM, nN, G, c, b_exp_rows;
    __device__ __forceinline__ bool next(int i, Unit& u) const {
        int tm, tn; if (!tile_order(i, G, c, nM, nN, tm, tn)) return false;
        const int e = __builtin_amdgcn_readfirstlane(tile_exp[tile0 + tm]);
        u.pm = tm; u.pn = tn; u.B_scale_off = e * b_exp_rows; u.A = A + (size_t)tm * a_tile_bytes; u.B = B + (size_t)e * b_exp_bytes + (size_t)tn * b_tile_bytes; return true;
    }
};

template <int MODE_> struct EpiBf16 {
    static constexpr bool PERM = true, AFTER_DRAIN = false, PREFETCH = false; static constexpr int MODE = MODE_;
    bf16_t* O; const float* sa; const float* sw; int ldc, ncols;
    __device__ __forceinline__ void operator()(const typename AccOf<MODE_>::T (&acc)[2][2][4][2], const Unit& u, int wr, int wc, int fr, int fq) const {
        const int row0 = u.pm * BM + wr * 64 + fr, col0 = u.pn * BM + wc * 32 + 8 * fq;
        f32x4 ws_[2][2];
        if constexpr (MODE_ == 1) {
#pragma unroll
            for (int bj = 0; bj < 2; ++bj) { ws_[bj][0] = *(const f32x4*)(sw + col0 + bj * HALF) * (1.f / 127.f); ws_[bj][1] = *(const f32x4*)(sw + col0 + bj * HALF + 4) * (1.f / 127.f); } }
#pragma unroll
        for (int ai = 0; ai < 2; ++ai)
#pragma unroll
            for (int m = 0; m < 4; ++m) { bf16_t* rowp = O + (size_t)(row0 + ai * HALF + m * 16) * ldc + col0; float rs = 1.f; if constexpr (MODE_ == 1) rs = sa[row0 + ai * HALF + m * 16];
#pragma unroll
                for (int bj = 0; bj < 2; ++bj) { if (col0 + bj * HALF < ncols) { f32x4 v0, v1; if constexpr (MODE_ == 1) { v0 = __builtin_convertvector(acc[ai][bj][m][0], f32x4) * (ws_[bj][0] * rs); v1 = __builtin_convertvector(acc[ai][bj][m][1], f32x4) * (ws_[bj][1] * rs); } else { v0 = acc[ai][bj][m][0]; v1 = acc[ai][bj][m][1]; }
                    u32x4 w; w.x = cvt_pk_bf16(v0[0], v0[1]); w.y = cvt_pk_bf16(v0[2], v0[3]); w.z = cvt_pk_bf16(v1[0], v1[1]); w.w = cvt_pk_bf16(v1[2], v1[3]);
                    *(u32x4*)(rowp + bj * HALF) = w; } } }
    }
};
__device__ __forceinline__ float silu_mul(float g, float u) { return g * u * __builtin_amdgcn_rcpf(1.f + __builtin_amdgcn_exp2f(-1.4426950408889634f * g)); }
template <int MODE_, bool SRC_F32> struct EpiResid {
    static constexpr bool PERM = false, AFTER_DRAIN = false, PREFETCH = false; static constexpr int MODE = MODE_;
    const void* lat_in; bf16_t* lat_out; const void* ctx_in; bf16_t* ctx_out; const float* gate; const float* sa; const float* sw; float oscale;
    __device__ __forceinline__ void operator()(const typename AccOf<MODE_>::T (&acc)[2][2][4][2], const Unit& u, int wr, int wc, int fr, int fq) const {
        const int b = u.pm / 33, j = u.pm % 33; const unsigned char* src; bf16_t* dst; int mr;
        if (j < 32) { const size_t off = ((size_t)b * SEQ + (size_t)j * 256) * DM; src = (const unsigned char*)lat_in + off * (SRC_F32 ? 4 : 2); dst = lat_out + off; mr = b; }
        else { const size_t off = (size_t)b * CTXL * DM; src = (const unsigned char*)ctx_in + off * (SRC_F32 ? 4 : 2); dst = ctx_out + off; mr = 4; }
        const int col0 = u.pn * BM + wc * 32 + 4 * fq; const float* gp = gate + (size_t)mr * 6144 + col0;
        f32x4 gv[2][2];
#pragma unroll
        for (int bj = 0; bj < 2; ++bj)
#pragma unroll
            for (int n = 0; n < 2; ++n) { gv[bj][n] = *(const f32x4*)(gp + bj * HALF + n * 16) * oscale; if constexpr (MODE_ == 1) gv[bj][n] = gv[bj][n] * *(const f32x4*)(sw + col0 + bj * HALF + n * 16); }
#pragma unroll
        for (int ai = 0; ai < 2; ++ai)
#pragma unroll
            for (int m = 0; m < 4; ++m) { const int rl = wr * 64 + fr + ai * HALF + m * 16; const size_t ro = (size_t)rl * DM + col0;
                float rs = 1.f; if constexpr (MODE_ == 1) rs = sa[u.pm * BM + rl];
#pragma unroll
                for (int bj = 0; bj < 2; ++bj)
#pragma unroll
                    for (int n = 0; n < 2; ++n) { const size_t e = ro + bj * HALF + n * 16; f32x4 x;
                        if constexpr (SRC_F32) x = *(const f32x4*)(src + e * 4); else { const u32x2 xb = *(const u32x2*)(src + e * 2); x = (f32x4){__uint_as_float(xb.x << 16), __uint_as_float(xb.x & 0xffff0000u), __uint_as_float(xb.y << 16), __uint_as_float(xb.y & 0xffff0000u)}; }
                        if constexpr (MODE_ == 1) x = x + (gv[bj][n] * rs) * __builtin_convertvector(acc[ai][bj][m][n], f32x4); else x = x + gv[bj][n] * acc[ai][bj][m][n];
                        *(u32x2*)(dst + e) = (u32x2){cvt_pk_bf16(x[0], x[1]), cvt_pk_bf16(x[2], x[3])}; } }
    }
};


__device__ __forceinline__ float clamp448(float x) { return fminf(fmaxf(x, -448.f), 448.f); }
template <bool F8OUT> struct EpiSwigluI8 {
    static constexpr bool PERM = true, AFTER_DRAIN = false, PREFETCH = true; static constexpr int MODE = 1;
    bf16_t* O; int ldc; const float* sa; const float* sw; PG8_LAS unsigned char* l;
    __device__ __forceinline__ void prefetch(const Unit& u, int wid, int lane) const {
        const float* src = (wid < 4) ? sa + (size_t)u.pm * BM + wid * 64 : sw + u.B_scale_off + u.pn * BM + (wid - 4) * 64;
        __builtin_amdgcn_global_load_lds((const unsigned*)(src + lane), (PG8_LAS unsigned*)(l + MISC_OFF + 4096 + u.par * 2048 + wid * 256), 4, 0, 0); }
    __device__ __forceinline__ void operator()(const i32x4 (&acc)[2][2][4][2], const Unit& u, int wr, int wc, int fr, int fq) const {
        const int row0 = u.pm * BM + wr * 64 + fr, col0 = u.pn * HALF + wc * 32 + 8 * fq;
        const PG8_LAS float* ls = (const PG8_LAS float*)(l + MISC_OFF + 4096 + u.par * 2048); const PG8_LAS float* swp = ls + 256 + wc * 32 + 8 * fq;
        const f32x4 wg0 = *(const PG8_LAS f32x4*)swp, wg1 = *(const PG8_LAS f32x4*)(swp + 4), wu0 = *(const PG8_LAS f32x4*)(swp + HALF), wu1 = *(const PG8_LAS f32x4*)(swp + HALF + 4);
#pragma unroll
        for (int ai = 0; ai < 2; ++ai)
#pragma unroll
            for (int m = 0; m < 4; ++m) { const int row = row0 + ai * HALF + m * 16; bf16_t* rowp = O + (size_t)row * ldc + col0; const float s = ls[wr * 64 + fr + ai * HALF + m * 16] * (1.f / 127.f);
                const i32x4 g0i = acc[ai][0][m][0], g1i = acc[ai][0][m][1], u0i = acc[ai][1][m][0], u1i = acc[ai][1][m][1];
                if constexpr (F8OUT) {
                    const f32x4 G0 = __builtin_convertvector(g0i, f32x4) * wg0, G1 = __builtin_convertvector(g1i, f32x4) * wg1, U0 = __builtin_convertvector(u0i, f32x4) * wu0, U1 = __builtin_convertvector(u1i, f32x4) * wu1;
                    const float c1 = -1.4426950408889634f * s, c2 = HID_SCALE * s * s;
#define SW8(G_, U_, i_) clamp448((G_[i_] * U_[i_]) * (c2 * __builtin_amdgcn_rcpf(1.f + __builtin_amdgcn_exp2f(G_[i_] * c1))))
                    int w0 = 0, w1 = 0;
                    w0 = __builtin_amdgcn_cvt_pk_fp8_f32(SW8(G0, U0, 0), SW8(G0, U0, 1), w0, false); w0 = __builtin_amdgcn_cvt_pk_fp8_f32(SW8(G0, U0, 2), SW8(G0, U0, 3), w0, true);
                    w1 = __builtin_amdgcn_cvt_pk_fp8_f32(SW8(G1, U1, 0), SW8(G1, U1, 1), w1, false); w1 = __builtin_amdgcn_cvt_pk_fp8_f32(SW8(G1, U1, 2), SW8(G1, U1, 3), w1, true);
#undef SW8
                    *(u32x2*)((unsigned char*)O + (size_t)row * ldc + col0) = (u32x2){(unsigned)w0, (unsigned)w1}; }
                else { const f32x4 g0 = __builtin_convertvector(g0i, f32x4) * (wg0 * s), g1 = __builtin_convertvector(g1i, f32x4) * (wg1 * s), u0 = __builtin_convertvector(u0i, f32x4) * (wu0 * s), u1 = __builtin_convertvector(u1i, f32x4) * (wu1 * s);
                    u32x4 w; w.x = cvt_pk_bf16(silu_mul(g0[0], u0[0]), silu_mul(g0[1], u0[1])); w.y = cvt_pk_bf16(silu_mul(g0[2], u0[2]), silu_mul(g0[3], u0[3]));
                    w.z = cvt_pk_bf16(silu_mul(g1[0], u1[0]), silu_mul(g1[1], u1[1])); w.w = cvt_pk_bf16(silu_mul(g1[2], u1[2]), silu_mul(g1[3], u1[3]));
                    *(u32x4*)rowp = w; } }
    }
};

struct EpiNullI8 {
    static constexpr bool PERM = true, AFTER_DRAIN = false, PREFETCH = false; static constexpr int MODE = 1;
    unsigned* O;
    __device__ __forceinline__ void operator()(const i32x4 (&acc)[2][2][4][2], const Unit& u, int wr, int wc, int fr, int fq) const {
        i32x4 s = acc[0][0][0][0];
#pragma unroll
        for (int ai = 0; ai < 2; ++ai)
#pragma unroll
            for (int bj = 0; bj < 2; ++bj)
#pragma unroll
                for (int m = 0; m < 4; ++m)
#pragma unroll
                    for (int n = 0; n < 2; ++n) s ^= acc[ai][bj][m][n];
        *(i32x4*)(O + ((size_t)(u.pm * 32 + u.pn) * 512 + threadIdx.x) * 4) = s;
    }
};

template <int MODE_> struct EpiCtxPart {
    static constexpr bool PERM = false, AFTER_DRAIN = false, PREFETCH = false; static constexpr int MODE = MODE_;
    float* part; const float* gate; const float* sa; const float* sw; float oscale; int pad_;
    __device__ __forceinline__ void operator()(const typename AccOf<MODE_>::T (&acc)[2][2][4][2], const Unit& u, int wr, int wc, int fr, int fq) const {
        const int b = u.pm / 33; float* dst = part + (size_t)b * CTXL * DM;
        const int col0 = u.pn * BM + wc * 32 + 4 * fq; const float* gp = gate + (size_t)4 * 6144 + col0;
        f32x4 gv[2][2];
#pragma unroll
        for (int bj = 0; bj < 2; ++bj)
#pragma unroll
            for (int n = 0; n < 2; ++n) { gv[bj][n] = *(const f32x4*)(gp + bj * HALF + n * 16) * oscale; if constexpr (MODE_ == 1) gv[bj][n] = gv[bj][n] * *(const f32x4*)(sw + col0 + bj * HALF + n * 16); }
#pragma unroll
        for (int ai = 0; ai < 2; ++ai)
#pragma unroll
            for (int m = 0; m < 4; ++m) { const int rl = wr * 64 + fr + ai * HALF + m * 16; const size_t ro = (size_t)rl * DM + col0; float rs = 1.f; if constexpr (MODE_ == 1) rs = sa[u.pm * BM + rl];
#pragma unroll
                for (int bj = 0; bj < 2; ++bj)
#pragma unroll
                    for (int n = 0; n < 2; ++n) { if constexpr (MODE_ == 1) *(f32x4*)(dst + ro + bj * HALF + n * 16) = (gv[bj][n] * rs) * __builtin_convertvector(acc[ai][bj][m][n], f32x4); else *(f32x4*)(dst + ro + bj * HALF + n * 16) = gv[bj][n] * acc[ai][bj][m][n]; } }
    }
};
template <class Epi, class Sched, bool ALIGN_EPI = false, bool SP2 = false>
__device__ __forceinline__ void gemm_phase(PG8_LAS unsigned char* lds, const int K, const int lda, const int ldb, const Sched S, const Epi E) {
    const int tid = otid(), wid = __builtin_amdgcn_readfirstlane(tid >> 6), lane = tid & 63, wr = wid >> 2, wc = wid & 3, fr = lane & 15, fq = lane >> 4;
    const int nt = K / BK;
    unsigned voffA[2], voffB[2];
#pragma unroll
    for (int i = 0; i < 2; ++i) { int R, C; stage_rc(tid * 16 + i * 8192, R, C); const int Rb = Epi::PERM ? ((R & ~31) + perm32(R & 31)) : R;
        voffA[i] = (unsigned)(R * lda + C) * 2u; voffB[i] = (unsigned)(Rb * ldb + C) * 2u; }
    const size_t kstep = (size_t)(BK * 2);
    const size_t hstepA = (size_t)HALF * lda * 2, hstepB = (size_t)HALF * ldb * 2;
    const unsigned ldsw = (unsigned)wid * 1024u;
    const int aoff = lds_byte(wr * 64 + fr, fq * 8), boff = lds_byte(wc * 32 + fr, fq * 8);
#define PG8_SA(b, h) (((b) * 2 + (h)) * HTB)
#define PG8_SB(b, h) ((4 + (b) * 2 + (h)) * HTB)
#define PG8_STAGE(bufoff, gbase, voff) do { _Pragma("unroll") for (int _i = 0; _i < 2; ++_i) \
        __builtin_amdgcn_global_load_lds((const unsigned*)((const char*)(gbase) + (voff)[_i]), (PG8_LAS unsigned*)(lds + (bufoff) + ldsw + _i * 8192), 16, 0, 0); } while (0)
#define PG8_LDA(dst, b, h) do { _Pragma("unroll") for (int m = 0; m < 4; ++m) { const bf16x8 lo_ = *(const PG8_LAS bf16x8*)(lds + PG8_SA(b, h) + aoff + m * 2048), hi_ = *(const PG8_LAS bf16x8*)(lds + PG8_SA(b, h) + aoff + m * 2048 + 1024); \
        if constexpr (Epi::MODE == 2) dst##8[m] = cat8(lo_, hi_); else { dst[m][0] = lo_; dst[m][1] = hi_; } } } while (0)
#define PG8_LDB(dst, b, h) do { _Pragma("unroll") for (int n = 0; n < 2; ++n) { const bf16x8 lo_ = *(const PG8_LAS bf16x8*)(lds + PG8_SB(b, h) + boff + n * 2048), hi_ = *(const PG8_LAS bf16x8*)(lds + PG8_SB(b, h) + boff + n * 2048 + 1024); \
        if constexpr (Epi::MODE == 2) dst##8[n] = cat8(lo_, hi_); else { dst[n][0] = lo_; dst[n][1] = hi_; } } } while (0)
#define PG8_MMA(ai, bj, At, Bt) do { __builtin_amdgcn_s_setprio(1); _Pragma("unroll") for (int m = 0; m < 4; ++m) _Pragma("unroll") for (int n = 0; n < 2; ++n) { \
        if constexpr (Epi::MODE == 2) asm volatile("v_mfma_f32_16x16x128_f8f6f4 %0, %1, %2, %0" : "+v"(acc[ai][bj][m][n]) : "v"(Bt##8[n]), "v"(At##8[m]));   \
        else { _Pragma("unroll") for (int k = 0; k < 2; ++k) acc[ai][bj][m][n] = mma16<Epi::MODE>(Bt[n][k], At[m][k], acc[ai][bj][m][n]); } } __builtin_amdgcn_s_setprio(0); } while (0)
#define PG8_WAIT_V(n) asm volatile("s_waitcnt vmcnt(" #n ")" ::: "memory")
#define PG8_WAIT_L(n) asm volatile("s_waitcnt lgkmcnt(" #n ")" ::: "memory")
#define PG8_BAR __builtin_amdgcn_s_barrier()
#define PG8_SCHED __builtin_amdgcn_sched_barrier(0)
    Unit cur, nxt; int ui = 0;
    if (!S.next(0, cur)) return;
    typedef typename AccOf<Epi::MODE>::T AccT;
    AccT acc[2][2][4][2];
#pragma unroll
    for (int a = 0; a < 2; ++a)
#pragma unroll
        for (int b = 0; b < 2; ++b)
#pragma unroll
            for (int m = 0; m < 4; ++m)
#pragma unroll
                for (int n = 0; n < 2; ++n) acc[a][b][m][n] = AccT{};
    bf16x8 At[4][2], B0[2][2], B1[2][2]; i32x8 At8[4], B08[2], B18[2];
    const char* cA = cur.A; const char* cB = cur.B;
    if constexpr (SP2) {
        PG8_STAGE(PG8_SB(0, 0), cB, voffB); PG8_STAGE(PG8_SB(0, 1), cB + hstepB, voffB); PG8_STAGE(PG8_SA(0, 0), cA, voffA); PG8_STAGE(PG8_SA(0, 1), cA + hstepA, voffA);
        if (wr == 1) PG8_BAR;
        PG8_WAIT_V(2); PG8_BAR;
        PG8_STAGE(PG8_SB(1, 0), cB + kstep, voffB); PG8_STAGE(PG8_SA(1, 0), cA + kstep, voffA); PG8_STAGE(PG8_SB(1, 1), cB + hstepB + kstep, voffB);
        PG8_WAIT_V(6); PG8_BAR;
    } else {
        PG8_STAGE(PG8_SB(0, 0), cB, voffB); PG8_STAGE(PG8_SA(0, 0), cA, voffA); PG8_STAGE(PG8_SB(0, 1), cB + hstepB, voffB); PG8_STAGE(PG8_SA(0, 1), cA + hstepA, voffA);
        if (wr == 1) PG8_BAR;
        PG8_WAIT_V(4); PG8_BAR;
        PG8_STAGE(PG8_SB(1, 0), cB + kstep, voffB); PG8_STAGE(PG8_SA(1, 0), cA + kstep, voffA); PG8_STAGE(PG8_SB(1, 1), cB + hstepB + kstep, voffB);
        PG8_WAIT_V(6); PG8_BAR;
    }
    for (;;) {
        cur.par = ui & 1; if constexpr (Epi::PREFETCH) E.prefetch(cur, wid, lane);
        const bool has_next = S.next(ui + 1, nxt);
        const char* nA = has_next ? nxt.A : cA; const char* nB = has_next ? nxt.B : cB;
        for (int t = 0; t < nt; t += 2) {
            const bool last = (t == nt - 2);
            const char* a1 = cA + (size_t)(t + 1) * kstep;
            const char* a2 = last ? nA : cA + (size_t)(t + 2) * kstep; const char* b2 = last ? nB : cB + (size_t)(t + 2) * kstep;
            const char* a3 = a2 + kstep; const char* b3 = b2 + kstep;
            if constexpr (SP2) {
            PG8_LDB(B0, 0, 0); PG8_LDB(B1, 0, 1); PG8_SCHED; PG8_LDA(At, 0, 0); PG8_STAGE(PG8_SA(1, 1), a1 + hstepA, voffA);
            PG8_WAIT_V(8); PG8_WAIT_L(0); PG8_BAR; PG8_MMA(0, 0, At, B0); PG8_MMA(0, 1, At, B1); PG8_BAR; PG8_SCHED;
            PG8_LDA(At, 0, 1); PG8_STAGE(PG8_SB(0, 0), b2, voffB); PG8_STAGE(PG8_SB(0, 1), b2 + hstepB, voffB); PG8_STAGE(PG8_SA(0, 0), a2, voffA);
            PG8_WAIT_V(8); PG8_WAIT_L(0); PG8_BAR; PG8_MMA(1, 0, At, B0); PG8_MMA(1, 1, At, B1); PG8_BAR; PG8_SCHED;
            PG8_LDB(B0, 1, 0); PG8_LDB(B1, 1, 1); PG8_SCHED; PG8_LDA(At, 1, 0); PG8_STAGE(PG8_SA(0, 1), a2 + hstepA, voffA);
            PG8_WAIT_V(8); PG8_WAIT_L(0); PG8_BAR; PG8_MMA(0, 0, At, B0); PG8_MMA(0, 1, At, B1); PG8_BAR; PG8_SCHED;
            PG8_LDA(At, 1, 1); PG8_STAGE(PG8_SB(1, 0), b3, voffB); PG8_STAGE(PG8_SB(1, 1), b3 + hstepB, voffB); PG8_STAGE(PG8_SA(1, 0), a3, voffA);
            PG8_WAIT_V(8); PG8_WAIT_L(0); PG8_BAR; PG8_MMA(1, 0, At, B0); PG8_MMA(1, 1, At, B1); PG8_BAR; PG8_SCHED;
            } else {
            PG8_LDB(B0, 0, 0); PG8_SCHED; PG8_LDA(At, 0, 0); PG8_STAGE(PG8_SA(1, 1), a1 + hstepA, voffA);
            PG8_WAIT_L(8); PG8_BAR; PG8_WAIT_L(0); PG8_MMA(0, 0, At, B0); PG8_BAR; PG8_SCHED;
            PG8_LDB(B1, 0, 1); PG8_STAGE(PG8_SB(0, 0), b2, voffB);
            PG8_BAR; PG8_WAIT_L(0); PG8_MMA(0, 1, At, B1); PG8_BAR;
            PG8_LDA(At, 0, 1); PG8_STAGE(PG8_SA(0, 0), a2, voffA);
            PG8_BAR; PG8_WAIT_L(0); PG8_MMA(1, 0, At, B0); PG8_BAR; PG8_SCHED;
            PG8_STAGE(PG8_SB(0, 1), b2 + hstepB, voffB);
            PG8_WAIT_V(6); PG8_BAR; PG8_MMA(1, 1, At, B1); PG8_BAR;
            PG8_LDB(B0, 1, 0); PG8_SCHED; PG8_LDA(At, 1, 0); PG8_STAGE(PG8_SA(0, 1), a2 + hstepA, voffA);
            PG8_WAIT_L(8); PG8_BAR; PG8_WAIT_L(0); PG8_MMA(0, 0, At, B0); PG8_BAR; PG8_SCHED;
            PG8_LDB(B1, 1, 1); PG8_STAGE(PG8_SB(1, 0), b3, voffB);
            PG8_BAR; PG8_WAIT_L(0); PG8_MMA(0, 1, At, B1); PG8_BAR;
            PG8_LDA(At, 1, 1); PG8_STAGE(PG8_SA(1, 0), a3, voffA);
            PG8_BAR; PG8_WAIT_L(0); PG8_MMA(1, 0, At, B0); PG8_BAR; PG8_SCHED;
            PG8_STAGE(PG8_SB(1, 1), b3 + hstepB, voffB);
            PG8_WAIT_V(6); PG8_BAR; PG8_MMA(1, 1, At, B1); PG8_BAR;
            }
        }
        if constexpr (ALIGN_EPI) { if (wr == 0) PG8_BAR; }
        if constexpr (Epi::MODE == 2) asm volatile("s_nop 15\n\ts_nop 15" ::: "memory");
        if constexpr (!Epi::AFTER_DRAIN) { E(acc, cur, wr, wc, fr, fq); }
        if (!has_next) break;
#pragma unroll
        for (int a = 0; a < 2; ++a)
#pragma unroll
            for (int b = 0; b < 2; ++b)
#pragma unroll
                for (int m = 0; m < 4; ++m)
#pragma unroll
                    for (int n = 0; n < 2; ++n) acc[a][b][m][n] = AccT{};
        cur = nxt; cA = nA; cB = nB; ++ui;
        if constexpr (ALIGN_EPI) { if (wr == 1) PG8_BAR; }
    }
    PG8_WAIT_V(0);
    if constexpr (!ALIGN_EPI) { if (wr == 0) PG8_BAR; }
    PG8_BAR;
#undef PG8_SA
#undef PG8_SB
#undef PG8_STAGE
#undef PG8_LDA
#undef PG8_LDB
#undef PG8_MMA
#undef PG8_WAIT_V
#undef PG8_WAIT_L
#undef PG8_BAR
#undef PG8_SCHED
}
}
#define XB_TMO      128
#define XB_XCNT(j)  (256  + 64 * (j))
#define XB_XSUB(j)  (1280 + 64 * (j))
#define XB_XGEN(j)  (2304 + 64 * (j))
#define XB_TOP      3328
#define XB_TOPGEN   3392
#define XCD_BAR_WORDS 3456
#define XB_SPIN_CAP (1u << 18)

__device__ __forceinline__ unsigned xb_ld(unsigned* p)              { return __hip_atomic_load(p, __ATOMIC_RELAXED, __HIP_MEMORY_SCOPE_AGENT); }
__device__ __forceinline__ unsigned xb_add(unsigned* p, unsigned v) { return __hip_atomic_fetch_add(p, v, __ATOMIC_RELAXED, __HIP_MEMORY_SCOPE_AGENT); }
__device__ __forceinline__ unsigned xb_xcc_id() { return (unsigned)__builtin_amdgcn_s_getreg((3 << 11) | 20) & 0xFu; }
#define XB_SPIN(cond, bar) do { unsigned _sp = 0; while (cond) { __builtin_amdgcn_s_sleep(1); \
    if ((++_sp & 255u) == 0u) { if (xb_ld(&(bar)[XB_TMO])) break; if (_sp > XB_SPIN_CAP) { atomicAdd(&(bar)[XB_TMO], 1u); break; } } } } while (0)

struct XcdBarrier {
    unsigned* bar; unsigned x;
    volatile LAS unsigned* st;
};

__device__ __forceinline__ XcdBarrier xcd_barrier_post(unsigned* bar, volatile LAS unsigned* st) {
    XcdBarrier b; b.bar = bar; b.x = xb_xcc_id(); b.st = st;
    if (threadIdx.x == 0) (void)xb_add(&bar[XB_XCNT(b.x)], 1u);
    return b;
}
__device__ __forceinline__ void xcd_barrier_complete(unsigned* bar, unsigned x, unsigned& nloc, unsigned& nx) {
    const unsigned G = gridDim.x * gridDim.y * gridDim.z;
    unsigned sum, cnt, mine, sp = 0u;
    for (;;) {
        sum = 0u; cnt = 0u; mine = 0u;
#pragma unroll
        for (unsigned j = 0; j < 16; ++j) { const unsigned c = xb_ld(&bar[XB_XCNT(j)]); sum += c; cnt += (c > 0u) ? 1u : 0u; mine = (j == x) ? c : mine; }
        if (sum == G) break;
        __builtin_amdgcn_s_sleep(1);
        if ((++sp & 255u) == 0u) { if (xb_ld(&bar[XB_TMO])) break; if (sp > XB_SPIN_CAP) { atomicAdd(&bar[XB_TMO], 1u); break; } }
    }
    nloc = mine > 0u ? mine : 1u; nx = cnt > 0u ? cnt : 1u;
}

__device__ __forceinline__ void xcd_barrier(const XcdBarrier& b) {
    asm volatile("s_waitcnt vmcnt(0)" ::: "memory");
    __syncthreads();
    if (threadIdx.x == 0) {
        unsigned* bar = b.bar;
        __builtin_amdgcn_s_waitcnt(0);
        unsigned nloc = b.st[0], nx = b.st[1];
        if (nloc == 0u) { xcd_barrier_complete(bar, b.x, nloc, nx); b.st[0] = nloc; b.st[1] = nx; }
        const unsigned old = xb_add(&bar[XB_XSUB(b.x)], 1u);
        const unsigned gen = old / nloc;
        if (old + 1u == (gen + 1u) * nloc) {
            __builtin_amdgcn_fence(__ATOMIC_RELEASE, "agent");
            asm volatile("s_waitcnt vmcnt(0)" ::: "memory");
            const unsigned og = xb_add(&bar[XB_TOP], 1u);
            const unsigned tg = og / nx;
            if (og + 1u == (tg + 1u) * nx) xb_add(&bar[XB_TOPGEN], 1u);
            else XB_SPIN(xb_ld(&bar[XB_TOPGEN]) == tg, bar);
            __builtin_amdgcn_fence(__ATOMIC_ACQUIRE, "agent");
            xb_add(&bar[XB_XGEN(b.x)], 1u);
            asm volatile("s_waitcnt vmcnt(0)" ::: "memory");
        } else {
            XB_SPIN(xb_ld(&bar[XB_XGEN(b.x)]) == gen, bar);
            __builtin_amdgcn_fence(__ATOMIC_ACQUIRE, "agent");
            asm volatile("s_waitcnt vmcnt(0)" ::: "memory");
        }
    }
    __syncthreads();
}
namespace att {
constexpr int KSLOT = 6144, VSLOT = 4096;
constexpr int L_K = 0, L_V = 4 * KSLOT, L_WS = L_V + 4 * VSLOT, L_OST = L_WS + 8 * 256, L_CONST = L_OST + 8 * 8192, L_END = L_CONST + 1536;
static_assert(L_END <= RING_BYTES, "attention LDS");
__device__ __forceinline__ int crow(int r, int hi) { return (r & 3) + 8 * (r >> 2) + 4 * hi; }
__device__ __forceinline__ unsigned pkbf(float lo, float hi) { f32x2 v = {lo, hi}; typedef __bf16 bf2 __attribute__((ext_vector_type(2))); bf2 b = __builtin_convertvector(v, bf2); return __builtin_bit_cast(unsigned, b); }
template <bool SAFE>
__device__ __forceinline__ bool attn_unit_impl(const unsigned char* Qw, const unsigned char* __restrict__ Kh, const unsigned char* __restrict__ Vt, bf16_t* Ow, int NT, int nwact, LAS unsigned char* shm) {
    const int tid = otid(), lane = tid & 63, r32 = lane & 31, hi = lane >> 5; const int wid = __builtin_amdgcn_readfirstlane(tid >> 6);
    const bool act = wid < nwact; asm volatile("" : "+s"(NT));
    const int vw = (wid + 2) & 7;
    LAS unsigned char* kd0 = shm + L_K + (wid < 6 ? wid : 0) * 1024; LAS unsigned char* vd = shm + L_V + (vw & 3) * 1024;
#define DMA_TILE(t, kslot, vslot) do { int l_ = lane; asm volatile("" : "+v"(l_)); \
        if (wid < 6) __builtin_amdgcn_global_load_lds((const unsigned*)(Kh + (size_t)(t) * 64 * 768 + ((unsigned)l_ * 768u + (unsigned)(wid < 6 ? wid : 0) * 16u)), (LAS unsigned*)(kd0 + (kslot) * KSLOT), 16, 0, 0); \
        if (vw < 4) __builtin_amdgcn_global_load_lds((const unsigned*)(Vt + (size_t)(t) * 4096 + ((unsigned)((vw & 3) * 16 + (l_ >> 2)) * 64u + (unsigned)(((l_ & 3) ^ ((l_ >> 4) & 3)) * 16))), (LAS unsigned*)(vd + (vslot) * VSLOT), 16, 0, 0); } while (0)
    pg8::i32x8 qa1, qa2, qb1, qb2;
    { const int wq = act ? wid : 0;
      const unsigned char* ra = Qw + (size_t)(wq * 64 + r32) * 768; const unsigned char* rb = ra + (size_t)32 * 768;
      const pg8::i32x4 z4 = {0, 0, 0, 0}, two4 = {0x40, 0, 0, 0};
      const pg8::i32x4 a0_ = *(const pg8::i32x4*)(ra + 32 * hi), a1_ = *(const pg8::i32x4*)(ra + 32 * hi + 16), a2_ = hi ? two4 : *(const pg8::i32x4*)(ra + 64), a3_ = hi ? z4 : *(const pg8::i32x4*)(ra + 80);
      const pg8::i32x4 b0_ = *(const pg8::i32x4*)(rb + 32 * hi), b1_ = *(const pg8::i32x4*)(rb + 32 * hi + 16), b2_ = hi ? two4 : *(const pg8::i32x4*)(rb + 64), b3_ = hi ? z4 : *(const pg8::i32x4*)(rb + 80);
      qa1 = __builtin_shufflevector(a0_, a1_, 0, 1, 2, 3, 4, 5, 6, 7); qa2 = __builtin_shufflevector(a2_, a3_, 0, 1, 2, 3, 4, 5, 6, 7);
      qb1 = __builtin_shufflevector(b0_, b1_, 0, 1, 2, 3, 4, 5, 6, 7); qb2 = __builtin_shufflevector(b2_, b3_, 0, 1, 2, 3, 4, 5, 6, 7); }
    if (tid < 384) ((LAS unsigned*)(shm + L_CONST))[tid] = (tid == 0 || tid == 64) ? 0xC0u : 0u;
    DMA_TILE(0, 0, 0);
    f32x16 oa[2], ob[2]; oa[0] = f32x16{}; oa[1] = f32x16{}; ob[0] = f32x16{}; ob[1] = f32x16{}; float la = 0.f, lb = 0.f, ovf = 0.f;
    const int keyr = 32 * ((r32 >> 2) & 1) + (r32 & 3) + 4 * (r32 >> 3);
    const LAS unsigned char* kp0 = shm + L_K + hi * 2048 + keyr * 16;
    const LAS unsigned char* kp1 = shm + L_K + 4096 + keyr * 16;
    const LAS unsigned char* kcc = shm + L_CONST;
    const int vsw = (r32 >> 2) & 3;
    const LAS unsigned char* vp0 = shm + L_V + r32 * 64 + ((2 * hi) ^ vsw) * 16;
    f32x16 a0, a1, b0, b1; pg8::i32x8 pa = {0, 0, 0, 0, 0, 0, 0, 0}, pb = {0, 0, 0, 0, 0, 0, 0, 0};
    pg8::i32x8 K0, K1, K0x, K1x, V0, V1;
#define MF8(A_, B_, C_) __builtin_amdgcn_mfma_scale_f32_32x32x64_f8f6f4(A_, B_, C_, 0, 0, 0, 0x7F7F7F7F, 0, 0x7F7F7F7F)
#define CAT8(x_, y_) __builtin_shufflevector(x_, y_, 0, 1, 2, 3, 4, 5, 6, 7)
#define LDK(ks_) do { const LAS unsigned char* kb = kp0 + (ks_) * KSLOT; const LAS unsigned char* kc = hi ? kcc : kp1 + (ks_) * KSLOT; \
        const pg8::i32x4 k0a = *(const LAS pg8::i32x4*)(kb), k0b = *(const LAS pg8::i32x4*)(kb + 1024), k1a = *(const LAS pg8::i32x4*)(kb + 256), k1b = *(const LAS pg8::i32x4*)(kb + 1280); \
        const pg8::i32x4 k0c = *(const LAS pg8::i32x4*)(kc), k0d = *(const LAS pg8::i32x4*)(kc + 1024), k1c = *(const LAS pg8::i32x4*)(kc + 256), k1d = *(const LAS pg8::i32x4*)(kc + 1280); \
        K0 = CAT8(k0a, k0b); K1 = CAT8(k1a, k1b); K0x = CAT8(k0c, k0d); K1x = CAT8(k1c, k1d); } while (0)
#define LDV(vs_) do { const LAS unsigned char* va = vp0 + (vs_) * VSLOT; const LAS unsigned char* vb = (const LAS unsigned char*)(uintptr_t)((unsigned)(uintptr_t)va ^ 16u);   \
        const pg8::i32x4 v0a = *(const LAS pg8::i32x4*)(va), v0b = *(const LAS pg8::i32x4*)(vb), v1a = *(const LAS pg8::i32x4*)(va + 2048), v1b = *(const LAS pg8::i32x4*)(vb + 2048); \
        V0 = CAT8(v0a, v0b); V1 = CAT8(v1a, v1b); } while (0)
#define PK4(o_, x_, i_) ({ int w_ = __builtin_amdgcn_cvt_pk_fp8_f32(SAFE ? fminf(x_[i_], 448.f) : x_[i_], SAFE ? fminf(x_[i_ + 1], 448.f) : x_[i_ + 1], o_, false); __builtin_amdgcn_cvt_pk_fp8_f32(SAFE ? fminf(x_[i_ + 2], 448.f) : x_[i_ + 2], SAFE ? fminf(x_[i_ + 3], 448.f) : x_[i_ + 3], w_, true); })
#define SOFT32(x0_, x1_, l_, p_) do { float s_ = 0.f; \
        _Pragma("unroll") for (int r = 0; r < 16; ++r) { x0_[r] = __builtin_amdgcn_exp2f(x0_[r]); x1_[r] = __builtin_amdgcn_exp2f(x1_[r]); s_ += x0_[r] + x1_[r]; } \
        l_ += s_; ovf = fmaxf(ovf, s_); \
        p_ = (pg8::i32x8){PK4(p_[0], x0_, 0), PK4(p_[1], x0_, 4), PK4(p_[2], x0_, 8), PK4(p_[3], x0_, 12), PK4(p_[4], x1_, 0), PK4(p_[5], x1_, 4), PK4(p_[6], x1_, 8), PK4(p_[7], x1_, 12)}; } while (0)
#define TOPSYNC() do { asm volatile("s_waitcnt vmcnt(0)" ::: "memory"); __builtin_amdgcn_s_barrier(); asm volatile("" ::: "memory"); } while (0)
    const f32x16 z16 = {};
    DMA_TILE(1, 1, 1);
    int sp = 0;
    for (int t = 0; t < NT; t += 2) {
        TOPSYNC();
        if (t + 2 < NT) { DMA_TILE(t + 2, sp ^ 2, sp ^ 2); DMA_TILE(t + 3, (sp ^ 2) + 1, (sp ^ 2) + 1); }
#pragma unroll 1
        for (int h = 0; h < 2; ++h) { const int ks = sp + h, vs = ks;
        LDK(ks);
        a0 = MF8(K0, qa1, z16); a1 = MF8(K1, qa1, z16); a0 = MF8(K0x, qa2, a0); a1 = MF8(K1x, qa2, a1);
        __builtin_amdgcn_sched_barrier(0);
        b0 = MF8(K0, qb1, z16); b1 = MF8(K1, qb1, z16); b0 = MF8(K0x, qb2, b0); b1 = MF8(K1x, qb2, b1);
        SOFT32(a0, a1, la, pa);
        __builtin_amdgcn_sched_barrier(0); LDV(vs);
        __builtin_amdgcn_sched_barrier(0);
        oa[0] = MF8(pa, V0, oa[0]); oa[1] = MF8(pa, V1, oa[1]);
        SOFT32(b0, b1, lb, pb);
        __builtin_amdgcn_sched_barrier(0);
        ob[0] = MF8(pb, V0, ob[0]); ob[1] = MF8(pb, V1, ob[1]);
        __builtin_amdgcn_sched_barrier(0);
        }
        sp ^= 2;
    }
#undef MF8
#undef CAT8
#undef LDK
#undef LDV
#undef PK4
#undef SOFT32
#undef TOPSYNC
#undef DMA_TILE
    { auto rr = __builtin_amdgcn_permlane32_swap(__float_as_uint(la), __float_as_uint(la), false, false); la = __uint_as_float(rr[0]) + __uint_as_float(rr[1]); }
    { auto rr = __builtin_amdgcn_permlane32_swap(__float_as_uint(lb), __float_as_uint(lb), false, false); lb = __uint_as_float(rr[0]) + __uint_as_float(rr[1]); }
    LAS float* wsf = (LAS float*)(shm + L_WS) + wid * 64;
    if (hi == 0) { wsf[r32] = la; wsf[32 + r32] = lb; }
    if (!SAFE) { if (__builtin_amdgcn_ballot_w64(ovf >= 448.f) != 0 && lane == 0) ((volatile LAS unsigned*)(shm + L_CONST))[380] = 1u; }
    asm volatile("s_waitcnt lgkmcnt(0)" ::: "memory");
    if (act) {
        LAS bf16_t* stg = (LAS bf16_t*)(shm + L_OST) + wid * 4096;
#pragma unroll
        for (int r = 0; r < 16; ++r) { const int orow = crow(r, hi); const float ra = __builtin_amdgcn_rcpf(wsf[orow]), rb = __builtin_amdgcn_rcpf(wsf[32 + orow]);
#pragma unroll
            for (int d0 = 0; d0 < 2; ++d0) { stg[orow * 64 + d0 * 32 + r32] = (bf16_t)(pkbf(oa[d0][r] * ra, 0.f) & 0xffffu); stg[(32 + orow) * 64 + d0 * 32 + r32] = (bf16_t)(pkbf(ob[d0][r] * rb, 0.f) & 0xffffu); } }
        asm volatile("s_waitcnt lgkmcnt(0)" ::: "memory");
#pragma unroll
        for (int i = 0; i < 8; ++i) { const int row = i * 8 + (lane >> 3), ch = lane & 7; const u32x4 v = *(const LAS u32x4*)(stg + row * 64 + ch * 8); *(u32x4*)(Ow + (size_t)(wid * 64 + row) * 512 + ch * 8) = v; }
    }
    asm volatile("s_waitcnt lgkmcnt(0)" ::: "memory"); __builtin_amdgcn_s_barrier(); asm volatile("" ::: "memory");
    bool redo = false;
    if (!SAFE) { redo = __builtin_amdgcn_readfirstlane((int)((volatile LAS unsigned*)(shm + L_CONST))[380]) != 0;
        asm volatile("s_waitcnt lgkmcnt(0)" ::: "memory"); __builtin_amdgcn_s_barrier(); asm volatile("" ::: "memory"); }
    return redo;
}
__device__ __forceinline__ void attn_unit(const unsigned char* Qw, const unsigned char* __restrict__ Kh, const unsigned char* __restrict__ Vt, bf16_t* Ow, int NT, int nwact, LAS unsigned char* shm) {
    if (attn_unit_impl<false>(Qw, Kh, Vt, Ow, NT, nwact, shm)) (void)attn_unit_impl<true>(Qw, Kh, Vt, Ow, NT, nwact, shm);
}
}
namespace fft {
constexpr size_t MIDC = (size_t)4 * 4 * 128 * 64 * 128;
__device__ __forceinline__ bf16x8 mk8(unsigned a, unsigned b, unsigned c, unsigned d) { u32x4 v = {a, b, c, d}; return __builtin_bit_cast(bf16x8, v); }
__device__ __forceinline__ unsigned pkbf(float lo, float hi) { return att::pkbf(lo, hi); }

__device__ __forceinline__ void fft1_phase(const bf16_t* P, bf16_t* MID, LAS unsigned char* lds, int vcu, int G) {
    const int tid = otid(), lane = tid & 63, c_ = lane & 15, q = lane >> 4; const int wid = __builtin_amdgcn_readfirstlane(tid >> 6);
    LAS unsigned char* Dl = lds; LAS unsigned char* ST = lds + 18432;
    int salt; asm volatile("v_mov_b32 %0, 0" : "=v"(salt));
    bf16x8 ccf[4], scf[4];
#pragma unroll
    for (int s = 0; s < 4; ++s) { unsigned cw[4], sw[4];
#pragma unroll
        for (int j = 0; j < 8; j += 2) { float s0, c0, s1, c1; const int m = 16 * wid + c_, ca = 32 * s + 8 * q + j + salt;
            sincospif((float)((ca * m) & 127) * (1.f / 64.f), &s0, &c0); sincospif((float)(((ca + 1) * m) & 127) * (1.f / 64.f), &s1, &c1);
            cw[j >> 1] = pkbf(c0, c1); sw[j >> 1] = pkbf(s0, s1); }
        ccf[s] = mk8(cw[0], cw[1], cw[2], cw[3]); scf[s] = mk8(sw[0], sw[1], sw[2], sw[3]); }
    bf16x8 c64f[4][2], s64f[4][2];
#pragma unroll
    for (int kt = 0; kt < 4; ++kt)
#pragma unroll
        for (int s = 0; s < 2; ++s) { unsigned cw[4], sw[4];
#pragma unroll
            for (int j = 0; j < 8; j += 2) { float s0, c0, s1, c1; const int k1 = 16 * kt + c_ + salt, t1 = 32 * s + (j < 4 ? 4 * q + j : 16 + 4 * q + j - 4);
                sincospif((float)((k1 * t1) & 63) * (1.f / 32.f), &s0, &c0); sincospif((float)((k1 * (t1 + 1)) & 63) * (1.f / 32.f), &s1, &c1);
                cw[j >> 1] = pkbf(c0, c1); sw[j >> 1] = pkbf(s0, s1); }
            c64f[kt][s] = mk8(cw[0], cw[1], cw[2], cw[3]); s64f[kt][s] = mk8(sw[0], sw[1], sw[2], sw[3]); }
    u32x4 nd0, nd1;
    { const int it0 = vcu < 2048 ? vcu : 0; const int b = it0 >> 9, g = (it0 >> 7) & 3, t2 = it0 & 127; const int row = tid >> 3, ch = tid & 7;
      const bf16_t* src = P + ((size_t)b * SB + 128 * row + t2) * INW + 544 + 128 * g + ch * 16; nd0 = *(const u32x4*)src; nd1 = *(const u32x4*)(src + 8); }
    for (int item = vcu; item < 2048; item += G) {
        const int b = item >> 9, g = (item >> 7) & 3, t2 = item & 127;
        { const int row = tid >> 3, ch = tid & 7;
          *(LAS u32x4*)(Dl + row * 288 + ch * 32) = nd0; *(LAS u32x4*)(Dl + row * 288 + ch * 32 + 16) = nd1;
          const int nit = (item + G < 2048) ? item + G : item; const int nb = nit >> 9, ng = (nit >> 7) & 3, nt2 = nit & 127;
          const bf16_t* src = P + ((size_t)nb * SB + 128 * row + nt2) * INW + 544 + 128 * ng + ch * 16; nd0 = *(const u32x4*)src; nd1 = *(const u32x4*)(src + 8); }
        __syncthreads();
        f32x4 aA[4], aB[4];
#pragma unroll
        for (int i = 0; i < 4; ++i) { aA[i] = (f32x4){0.f, 0.f, 0.f, 0.f}; aB[i] = (f32x4){0.f, 0.f, 0.f, 0.f}; }
#pragma unroll
        for (int s = 0; s < 4; ++s)
#pragma unroll
            for (int i = 0; i < 4; ++i) { const bf16x8 af = *(const LAS bf16x8*)(Dl + (16 * i + c_) * 288 + (32 * s + 8 * q) * 2);
                aA[i] = __builtin_amdgcn_mfma_f32_16x16x32_bf16(af, ccf[s], aA[i], 0, 0, 0); aB[i] = __builtin_amdgcn_mfma_f32_16x16x32_bf16(af, scf[s], aB[i], 0, 0, 0); }
        unsigned xa[4][2], xb[4][2];
#pragma unroll
        for (int i = 0; i < 4; ++i) { xa[i][0] = pkbf(aA[i][0], aA[i][1]); xa[i][1] = pkbf(aA[i][2], aA[i][3]); xb[i][0] = pkbf(aB[i][0], aB[i][1]); xb[i][1] = pkbf(aB[i][2], aB[i][3]); }
        bf16x8 fA[2], fB[2], fNB[2];
#pragma unroll
        for (int s = 0; s < 2; ++s) { fA[s] = mk8(xa[2 * s][0], xa[2 * s][1], xa[2 * s + 1][0], xa[2 * s + 1][1]); fB[s] = mk8(xb[2 * s][0], xb[2 * s][1], xb[2 * s + 1][0], xb[2 * s + 1][1]);
            fNB[s] = mk8(xb[2 * s][0] ^ 0x80008000u, xb[2 * s][1] ^ 0x80008000u, xb[2 * s + 1][0] ^ 0x80008000u, xb[2 * s + 1][1] ^ 0x80008000u); }
#pragma unroll
        for (int kt = 0; kt < 4; ++kt) { f32x4 yr = (f32x4){0.f, 0.f, 0.f, 0.f}, wi = (f32x4){0.f, 0.f, 0.f, 0.f};
#pragma unroll
            for (int s = 0; s < 2; ++s) {
                yr = __builtin_amdgcn_mfma_f32_16x16x32_bf16(fA[s], c64f[kt][s], yr, 0, 0, 0); yr = __builtin_amdgcn_mfma_f32_16x16x32_bf16(fNB[s], s64f[kt][s], yr, 0, 0, 0);
                wi = __builtin_amdgcn_mfma_f32_16x16x32_bf16(fB[s], c64f[kt][s], wi, 0, 0, 0); wi = __builtin_amdgcn_mfma_f32_16x16x32_bf16(fA[s], s64f[kt][s], wi, 0, 0, 0); }
            const int k1 = 16 * kt + c_; float ts, tr; sincospif((float)(k1 * t2) * (1.f / 4096.f), &ts, &tr);
            const f32x4 ypr = yr * tr - wi * ts, wpi = yr * ts + wi * tr;
            LAS unsigned char* sp = ST + k1 * 272 + (16 * wid + 4 * q) * 2;
            *(LAS u32x2*)sp = (u32x2){pkbf(ypr[0], ypr[1]), pkbf(ypr[2], ypr[3])}; *(LAS u32x2*)(sp + 17408) = (u32x2){pkbf(wpi[0], wpi[1]), pkbf(wpi[2], wpi[3])}; }
        __syncthreads();
#pragma unroll
        for (int p = 0; p < 4; ++p) { const int idx = p * 512 + tid, comp = idx >> 10, rem = idx & 1023, k1 = rem >> 4, ch = rem & 15;
            const u32x4 v = *(const LAS u32x4*)(ST + comp * 17408 + k1 * 272 + ch * 16);
            *(u32x4*)(MID + comp * MIDC + ((((size_t)b * 4 + g) * 128 + t2) * 64 + k1) * 128 + ch * 8) = v; }
    }
    __syncthreads();
}

__device__ __forceinline__ void fft2_phase(const bf16_t* MID, bf16_t* FOUR, LAS unsigned char* lds, int vcu, int G) {
    const int tid = otid(), lane = tid & 63, r32 = lane & 31, hi = lane >> 5; const int wid = __builtin_amdgcn_readfirstlane(tid >> 6), kt = wid & 3, mh = wid >> 2;
    LAS unsigned char* DT = lds; LAS unsigned char* ST = lds + 65536;
    int salt; asm volatile("v_mov_b32 %0, 0" : "=v"(salt));
    bf16x8 cf[8], nsf[8];
#pragma unroll
    for (int s = 0; s < 8; ++s) { unsigned cw[4], sw[4];
#pragma unroll
        for (int j = 0; j < 8; j += 2) { float s0, c0, s1, c1; const int k2 = 32 * kt + r32 + salt, t2 = 16 * s + (j < 4 ? 4 * hi + j : 8 + 4 * hi + j - 4);
            sincospif((float)((k2 * t2) & 127) * (1.f / 64.f), &s0, &c0); sincospif((float)((k2 * (t2 + 1)) & 127) * (1.f / 64.f), &s1, &c1);
            cw[j >> 1] = pkbf(c0, c1); sw[j >> 1] = pkbf(-s0, -s1); }
        cf[s] = mk8(cw[0], cw[1], cw[2], cw[3]); nsf[s] = mk8(sw[0], sw[1], sw[2], sw[3]); }
    const int vb = (int)(unsigned)(uintptr_t)DT + mh * 16384 + ((lane >> 4) & 1) * 32 + (lane & 3) * 8 + (4 * hi + ((lane & 15) >> 2)) * 64;
    for (int item = vcu; item < 1024; item += G) {
        const int b = item >> 8, g = (item >> 6) & 3, k1 = item & 63;
        u32x4 dv[2][4];
#pragma unroll
        for (int comp = 0; comp < 2; ++comp)
#pragma unroll
            for (int i = 0; i < 4; ++i) { const int idx = i * 512 + tid, t2 = idx >> 4, ch = idx & 15;
                dv[comp][i] = *(const u32x4*)(MID + comp * MIDC + ((((size_t)b * 4 + g) * 128 + t2) * 64 + k1) * 128 + ch * 8); }
#pragma unroll
        for (int comp = 0; comp < 2; ++comp)
#pragma unroll
            for (int i = 0; i < 4; ++i) { const int idx = i * 512 + tid, t2 = idx >> 4, ch = idx & 15;
                *(LAS u32x4*)(DT + comp * 32768 + (ch >> 2) * 8192 + (t2 >> 4) * 1024 + (t2 & 15) * 64 + (ch & 3) * 16) = dv[comp][i]; }
        __syncthreads();
        f32x16 acc[2]; acc[0] = f32x16{}; acc[1] = f32x16{};
#pragma unroll
        for (int mql = 0; mql < 2; ++mql)
#pragma unroll
            for (int s = 0; s < 8; ++s) { s16x4 l0, h0, l1, h1;
                asm volatile("ds_read_b64_tr_b16 %0,%1 offset:%c2" : "=&v"(l0) : "v"(vb), "i"(mql * 8192 + s * 1024) : "memory");
                asm volatile("ds_read_b64_tr_b16 %0,%1 offset:%c2" : "=&v"(h0) : "v"(vb), "i"(mql * 8192 + s * 1024 + 512) : "memory");
                asm volatile("ds_read_b64_tr_b16 %0,%1 offset:%c2" : "=&v"(l1) : "v"(vb), "i"(32768 + mql * 8192 + s * 1024) : "memory");
                asm volatile("ds_read_b64_tr_b16 %0,%1 offset:%c2" : "=&v"(h1) : "v"(vb), "i"(32768 + mql * 8192 + s * 1024 + 512) : "memory");
                asm volatile("s_waitcnt lgkmcnt(0)" ::: "memory"); __builtin_amdgcn_sched_barrier(0);
                const bf16x8 a0 = (bf16x8){l0[0], l0[1], l0[2], l0[3], h0[0], h0[1], h0[2], h0[3]}, a1 = (bf16x8){l1[0], l1[1], l1[2], l1[3], h1[0], h1[1], h1[2], h1[3]};
                acc[mql] = __builtin_amdgcn_mfma_f32_32x32x16_bf16(a0, cf[s], acc[mql], 0, 0, 0); acc[mql] = __builtin_amdgcn_mfma_f32_32x32x16_bf16(a1, nsf[s], acc[mql], 0, 0, 0); }
        const int k2 = 32 * kt + r32;
#pragma unroll
        for (int mql = 0; mql < 2; ++mql)
#pragma unroll
            for (int a = 0; a < 4; ++a) { const int m = 32 * (2 * mh + mql) + 8 * a + 4 * hi; const float sc = 1.f / 1024.f;
                *(LAS u32x2*)(ST + k2 * 272 + m * 2) = (u32x2){pkbf(acc[mql][4 * a] * sc, acc[mql][4 * a + 1] * sc), pkbf(acc[mql][4 * a + 2] * sc, acc[mql][4 * a + 3] * sc)}; }
        __syncthreads();
#pragma unroll
        for (int p = 0; p < 4; ++p) { const int idx = p * 512 + tid, kk = idx >> 4, ch = idx & 15;
            const u32x4 v = *(const LAS u32x4*)(ST + kk * 272 + ch * 16);
            *(u32x4*)(FOUR + ((size_t)b * SB + k1 + 64 * kk) * 512 + g * 128 + ch * 8) = v; }
    }
    __syncthreads();
}

__device__ __forceinline__ void ctxfour_phase(const bf16_t* P, bf16_t* FOUR, LAS unsigned char* lds, int vcu, int G) {
    const int tid = otid(), lane = tid & 63, fr = lane & 15, fq = lane >> 4; const int wid = __builtin_amdgcn_readfirstlane(tid >> 6);
    LAS unsigned short* Dl = (LAS unsigned short*)lds;
    LAS float* ct = (LAS float*)(lds + 69632); LAS float* st = ct + 256;
    LAS unsigned short* Zl = (LAS unsigned short*)(lds + 71680);
    LAS unsigned short* Ol = (LAS unsigned short*)(lds + 71680 + 8448);
    if (tid < 256) { float s, c; sincospif((float)tid * (1.f / 128.f), &s, &c); ct[tid] = c; st[tid] = s; }
    for (int item = vcu; item < 256; item += G) {
        const int b = item >> 6, g = (item >> 4) & 3, mc = item & 15, m0 = 8 * mc;
        __syncthreads();
#pragma unroll
        for (int i = 0; i < 8; ++i) { const int idx = i * 512 + tid, t = idx >> 4, ch = idx & 15;
            const u32x4 v = *(const u32x4*)(P + ((size_t)b * SB + SEQ + t) * INW + 544 + 128 * g + ch * 8);
            *(LAS u32x4*)((LAS unsigned char*)Dl + t * 272 + ch * 16) = v; }
        __syncthreads();
        bf16x8 tw[4];
        { const int m = m0 + (fr & 7); const LAS float* tb = (fr < 8) ? ct : st;
#pragma unroll
          for (int ks = 0; ks < 4; ++ks) { float v[8];
#pragma unroll
              for (int i = 0; i < 8; ++i) v[i] = tb[(2 * m * (32 * ks + 8 * fq + i)) & 255];
              tw[ks] = mk8(pkbf(v[0], v[1]), pkbf(v[2], v[3]), pkbf(v[4], v[5]), pkbf(v[6], v[7])); } }
#pragma unroll
        for (int tt = 0; tt < 2; ++tt) { const int tile = 2 * wid + tt; f32x4 acc = {0.f, 0.f, 0.f, 0.f};
#pragma unroll
            for (int ks = 0; ks < 4; ++ks) { const bf16x8 a = *(const LAS bf16x8*)((const LAS unsigned char*)Dl + (16 * tile + fr) * 272 + (32 * ks + 8 * fq) * 2);
                acc = __builtin_amdgcn_mfma_f32_16x16x32_bf16(a, tw[ks], acc, 0, 0, 0); }
            *(LAS u32x2*)(Zl + fr * 264 + 16 * tile + 4 * fq) = (u32x2){pkbf(acc[0], acc[1]), pkbf(acc[2], acc[3])}; }
        __syncthreads();
#pragma unroll 1
        for (int kt = 0; kt < 2; ++kt) { const int tile = 2 * wid + kt, k = 16 * tile + fr; f32x4 acc = {0.f, 0.f, 0.f, 0.f};
#pragma unroll 4
            for (int ks = 0; ks < 16; ++ks) { const int part = ks >> 3, t0 = 32 * (ks & 7) + 8 * fq; float v[8];
#pragma unroll
                for (int i = 0; i < 8; ++i) { const int idx = (k * (t0 + i)) & 255; v[i] = part ? -st[idx] : ct[idx]; }
                const bf16x8 a = mk8(pkbf(v[0], v[1]), pkbf(v[2], v[3]), pkbf(v[4], v[5]), pkbf(v[6], v[7]));
                const bf16x8 bz = *(const LAS bf16x8*)(Zl + (part * 8 + (fr & 7)) * 264 + t0);
                acc = __builtin_amdgcn_mfma_f32_16x16x32_bf16(a, bz, acc, 0, 0, 0); }
            const float sc = 0.005524271728019903f;
            if (fr < 8) {
#pragma unroll
                for (int r = 0; r < 4; ++r) Ol[(16 * tile + 4 * fq + r) * 8 + fr] = (unsigned short)(pkbf(acc[r] * sc, 0.f) & 0xffffu); } }
        __syncthreads();
        if (tid < 256) *(u32x4*)(FOUR + ((size_t)b * SB + SEQ + tid) * 512 + g * 128 + m0) = *(const LAS u32x4*)(Ol + tid * 8);
    }
    __syncthreads();
}
}
__device__ __forceinline__ unsigned pk2(float lo, float hi) { return att::pkbf(lo, hi); }
__device__ __forceinline__ float c448(float x) { return __builtin_amdgcn_fmed3f(x, -448.f, 448.f); }
__device__ __forceinline__ unsigned pk4f8(float a, float b, float c, float d) { int w = 0; w = __builtin_amdgcn_cvt_pk_fp8_f32(c448(a), c448(b), w, false); w = __builtin_amdgcn_cvt_pk_fp8_f32(c448(c), c448(d), w, true); return (unsigned)w; }

__device__ __forceinline__ void tr_item(const float* W, int ldw, int k0, int n0, bf16_t* WT, int ldk, int orow0, const float* ks, LAS float* scr, int lane) {
#pragma unroll 8
    for (int i = 0; i < 32; ++i) { const int kk = 2 * i + (lane >> 5); float v = W[(size_t)(k0 + kk) * ldw + n0 + (lane & 31)]; if (ks) v *= ks[k0 + kk]; scr[kk * 33 + (lane & 31)] = v; }
    LDS_WAIT(); asm volatile("" ::: "memory");
    const int c = lane & 7;
#pragma unroll
    for (int j = 0; j < 4; ++j) { const int n = (lane >> 3) + 8 * j; const LAS float* s = scr + (8 * c) * 33 + n;
        u32x4 o; o.x = pk2(s[0 * 33], s[1 * 33]); o.y = pk2(s[2 * 33], s[3 * 33]); o.z = pk2(s[4 * 33], s[5 * 33]); o.w = pk2(s[6 * 33], s[7 * 33]);
        *(u32x4*)(WT + (size_t)(orow0 + n) * ldk + k0 + 8 * c) = o; }
    LDS_WAIT(); asm volatile("" ::: "memory");
}
__device__ __forceinline__ void conv_mat(const float* W, int K, int N, bf16_t* WT, int mode, const float* ks, int& off, int gw, int NGW, LAS float* scr, int lane) {
    const int nnb = N / 32, items = (K / 64) * nnb;
    const int start = (gw + NGW - (off % NGW)) % NGW;
    for (int it = start; it < items; it += NGW) { const int kb = it / nnb, nb = it - kb * nnb, n0 = nb * 32;
        const int orow0 = (mode == 0) ? n0 : 256 * (n0 >> 7) + 128 * (mode - 1) + (n0 & 127);
        tr_item(W, N, kb * 64, n0, WT, K, orow0, ks, scr, lane); }
    off += items;
}

__device__ __forceinline__ void conv_mat_f8(const float* W, int K, int N, unsigned char* WT, float sc, int& off, int gw, int NGW, LAS float* scr, int lane) {
    const int nnb = N / 32, items = (K / 64) * nnb;
    const int start = (gw + NGW - (off % NGW)) % NGW;
    for (int it = start; it < items; it += NGW) { const int kb = it / nnb, nb = it - kb * nnb, n0 = nb * 32;
        const float* p = W + (size_t)(kb * 64 + (lane >> 5)) * N + n0 + (lane & 31); const size_t st = (size_t)2 * N; LAS float* sq = scr + (lane >> 5) * 33 + (lane & 31);
#pragma unroll 8
        for (int i = 0; i < 32; ++i) { sq[(2 * i) * 33] = *p * sc; p += st; }
        LDS_WAIT(); asm volatile("" ::: "memory");
        const int n = lane >> 1, hf = lane & 1; const LAS float* sp = scr + (32 * hf) * 33 + n; int pk[8];
#pragma unroll
        for (int j = 0; j < 8; ++j) { int w = 0; w = __builtin_amdgcn_cvt_pk_fp8_f32(sp[(4 * j) * 33], sp[(4 * j + 1) * 33], w, false); w = __builtin_amdgcn_cvt_pk_fp8_f32(sp[(4 * j + 2) * 33], sp[(4 * j + 3) * 33], w, true); pk[j] = w; }
        u32x4* dst = (u32x4*)(WT + (size_t)(n0 + n) * K + kb * 64 + 32 * hf);
        dst[0] = (u32x4){(unsigned)pk[0], (unsigned)pk[1], (unsigned)pk[2], (unsigned)pk[3]}; dst[1] = (u32x4){(unsigned)pk[4], (unsigned)pk[5], (unsigned)pk[6], (unsigned)pk[7]};
        LDS_WAIT(); asm volatile("" ::: "memory"); }
    off += items;
}
constexpr int QW_BUF = 69632, QW_STRIDE = 1040, QW_CM = QW_BUF + 32 * QW_STRIDE;
static_assert(QW_CM + 1024 <= RING_BYTES, "quantiser LDS");
__device__ __forceinline__ void quant_wg(const float* W, int N, signed char* WT, float* cm, int mode, int& off, int vcu, int G, LAS unsigned char* lds, int tid) {
    const int items = N / 32, start = (vcu + G - (off % G)) % G;
    const int w = __builtin_amdgcn_readfirstlane(tid >> 6), lane = tid & 63, r = lane >> 3, c = lane & 7;
    LAS float* cml = (LAS float*)(lds + QW_CM);
    for (int it = start; it < items; it += G) { const int n0 = it * 32;
        const int orow0 = (mode == 0) ? n0 : 256 * (n0 >> 7) + 128 * (mode - 1) + (n0 & 127);
        const float* src = W + (size_t)(128 * w + 4 * r) * N + n0 + 4 * c;
        f32x4 v[16];
#pragma unroll
        for (int b = 0; b < 4; ++b)
#pragma unroll
            for (int dk = 0; dk < 4; ++dk) v[4 * b + dk] = *(const f32x4*)(src + (size_t)(32 * b + dk) * N);
        f32x4 m = {0.f, 0.f, 0.f, 0.f};
#pragma unroll
        for (int i = 0; i < 16; ++i) { m.x = fmaxf(m.x, fabsf(v[i].x)); m.y = fmaxf(m.y, fabsf(v[i].y)); m.z = fmaxf(m.z, fabsf(v[i].z)); m.w = fmaxf(m.w, fabsf(v[i].w)); }
#pragma unroll
        for (int o = 8; o < 64; o <<= 1) { m.x = fmaxf(m.x, __shfl_xor(m.x, o)); m.y = fmaxf(m.y, __shfl_xor(m.y, o)); m.z = fmaxf(m.z, __shfl_xor(m.z, o)); m.w = fmaxf(m.w, __shfl_xor(m.w, o)); }
        if (r == 0) *(LAS f32x4*)(cml + w * 32 + 4 * c) = m;
        __syncthreads();
        f32x4 mx = *(const LAS f32x4*)(cml + 4 * c);
#pragma unroll
        for (int ww = 1; ww < 8; ++ww) { const f32x4 t = *(const LAS f32x4*)(cml + ww * 32 + 4 * c); mx.x = fmaxf(mx.x, t.x); mx.y = fmaxf(mx.y, t.y); mx.z = fmaxf(mx.z, t.z); mx.w = fmaxf(mx.w, t.w); }
        if (w == 0 && r == 0) *(f32x4*)(cm + orow0 + 4 * c) = mx;
        const f32x4 inv = {mx.x > 0.f ? 127.f / mx.x : 0.f, mx.y > 0.f ? 127.f / mx.y : 0.f, mx.z > 0.f ? 127.f / mx.z : 0.f, mx.w > 0.f ? 127.f / mx.w : 0.f};
        LAS unsigned char* img = lds + QW_BUF + 128 * w + 4 * r;
#pragma unroll
        for (int b = 0; b < 4; ++b) {
#define QW_PK(comp_, j_) { const int q0 = (int)rintf(v[4 * b].comp_ * inv.comp_), q1 = (int)rintf(v[4 * b + 1].comp_ * inv.comp_), q2 = (int)rintf(v[4 * b + 2].comp_ * inv.comp_), q3 = (int)rintf(v[4 * b + 3].comp_ * inv.comp_); \
            *(LAS unsigned*)(img + (4 * c + j_) * QW_STRIDE + 32 * b) = (unsigned)(q0 & 255) | ((unsigned)(q1 & 255) << 8) | ((unsigned)(q2 & 255) << 16) | ((unsigned)(q3 & 255) << 24); }
            QW_PK(x, 0) QW_PK(y, 1) QW_PK(z, 2) QW_PK(w, 3)
#undef QW_PK
        }
        __syncthreads();
        { const int n = tid >> 4, ch = tid & 15; const LAS u32x4* sp = (const LAS u32x4*)(lds + QW_BUF + n * QW_STRIDE + ch * 64); u32x4* dp = (u32x4*)(WT + (size_t)(orow0 + n) * 1024 + ch * 64);
          const u32x4 x0 = sp[0], x1 = sp[1], x2 = sp[2], x3 = sp[3]; dp[0] = x0; dp[1] = x1; dp[2] = x2; dp[3] = x3; }
        __syncthreads();
    }
    off += items;
}

struct Args { const float* in[25]; float* out; unsigned char* ws; int pad0, pad1; };
typedef const Args __attribute__((address_space(4))) KArgs;
__device__ __forceinline__ KArgs* KA() { KArgs* p = (KArgs*)__builtin_amdgcn_kernarg_segment_ptr(); asm volatile("" : "+s"(p)); return p; }
struct Ctx {
    float* out; unsigned char* ws;
    int tid, lane, wave, vcu, G, gw, NGW;
    LAS unsigned char* lds;
};
enum { I_X = 0, I_C, I_CTX, I_CCTX, I_WADA, I_BADA, I_NORM1, I_WIN, I_QLN, I_KVLN, I_WUQ, I_WUKV, I_QN, I_KN, I_ONA, I_ONF, I_WOUT, I_NORM2, I_FG, I_FU, I_FD, I_WR, I_MG, I_MU, I_MD };

__device__ __forceinline__ void conv_dense_weights(const Ctx& C) {
    KArgs* A = KA();
    LAS float* scr = (LAS float*)(C.lds + C.wave * 8448); int off = 0;
    for (int l = 0; l < DEPTH; ++l) {
        conv_mat(A->in[I_WUQ] + (size_t)l * 256 * 768, 256, 768, (bf16_t*)(C.ws + WS_WUQ) + (size_t)l * 768 * 256, 0, A->in[I_QLN] + l * 256, off, C.gw, C.NGW, scr, C.lane);
        conv_mat(A->in[I_WUKV] + (size_t)l * 256 * 1024, 256, 1024, (bf16_t*)(C.ws + WS_WUKV) + (size_t)l * 1024 * 256, 0, A->in[I_KVLN] + l * 256, off, C.gw, C.NGW, scr, C.lane);
    }
    for (int i = 0; i < 2; ++i) {
        conv_mat_f8(A->in[I_FD] + (size_t)i * FFN * DM, FFN, DM, (unsigned char*)(C.ws + WS_WD) + (size_t)i * DM * FFN, WD_SCALE, off, C.gw, C.NGW, scr, C.lane);
    }
    for (int l = 0; l < DEPTH; ++l) { u32x4* z = (u32x4*)((signed char*)(C.ws + WS_WIN) + ((size_t)l * 1280 + INW) * DM);
        for (int i = C.gw * 64 + C.lane; i < 224 * DM / 16; i += C.NGW * 64) z[i] = (u32x4){0u, 0u, 0u, 0u}; }
}
__device__ __forceinline__ void conv_moe(const Ctx& C, int i) {
    KArgs* A = KA();
    LAS float* scr = (LAS float*)(C.lds + C.wave * 8448); int off = 0, offw = 0;
    float* cm = (float*)(C.ws + WS_SCL + SCL_SWM) + (size_t)i * 8 * 7168;
    for (int e = 0; e < NE; ++e) {
        const size_t wo = ((size_t)i * NE + e) * DM * MFF;
        quant_wg(A->in[I_MG] + wo, MFF, (signed char*)(C.ws + WS_MGU) + (size_t)e * 7168 * DM, cm + e * 7168, 1, offw, C.vcu, C.G, C.lds, C.tid);
        quant_wg(A->in[I_MU] + wo, MFF, (signed char*)(C.ws + WS_MGU) + (size_t)e * 7168 * DM, cm + e * 7168, 2, offw, C.vcu, C.G, C.lds, C.tid);
    }
    for (int e = 0; e < NE; ++e) {
        const size_t wo = ((size_t)i * NE + e) * DM * MFF;
        conv_mat_f8(A->in[I_MD] + wo, MFF, DM, (unsigned char*)(C.ws + WS_MD) + (size_t)e * DM * MFF, WD_SCALE, off, C.gw, C.NGW, scr, C.lane);
    }
}
__device__ __forceinline__ void conv_gu(const Ctx& C) {
    KArgs* A = KA(); int offw = 0;
    for (int i = 0; i < 2; ++i) { float* cm = (float*)(C.ws + WS_SCL + SCL_SWD) + i * 5632;
        quant_wg(A->in[I_FG] + (size_t)i * DM * FFN, FFN, (signed char*)(C.ws + WS_WGU) + (size_t)i * 5632 * DM, cm, 1, offw, C.vcu, C.G, C.lds, C.tid);
        quant_wg(A->in[I_FU] + (size_t)i * DM * FFN, FFN, (signed char*)(C.ws + WS_WGU) + (size_t)i * 5632 * DM, cm, 2, offw, C.vcu, C.G, C.lds, C.tid); }
    for (int l = 0; l < DEPTH; ++l) quant_wg(A->in[I_WOUT] + (size_t)l * DM * DM, DM, (signed char*)(C.ws + WS_WOUT) + (size_t)l * DM * DM, (float*)(C.ws + WS_SCL + SCL_SWO) + l * DM, 0, offw, C.vcu, C.G, C.lds, C.tid);
    for (int l = 0; l < DEPTH; ++l) quant_wg(A->in[I_WIN] + (size_t)l * DM * INW, INW, (signed char*)(C.ws + WS_WIN) + (size_t)l * 1280 * DM, (float*)(C.ws + WS_SCL + SCL_SWI) + l * 1280, 0, offw, C.vcu, C.G, C.lds, C.tid);
}
__device__ __forceinline__ void ada_phase(const Ctx& C) {
    KArgs* A = KA();
    LAS float* sl = (LAS float*)C.lds; LAS float* red = sl + 5 * 1024;
    for (int i = C.tid; i < 5 * 1024; i += 512) { const int r = i >> 10, k = i & 1023; const float v = (r < 4) ? A->in[I_C][r * 1024 + k] : A->in[I_CCTX][k]; sl[i] = v / (1.f + expf(-v)); }
    __syncthreads();
    float* mod = (float*)(C.ws + WS_MOD);
    for (int it = C.vcu; it < 4 * 64; it += C.G) { const int l = it >> 6, n0 = (it & 63) * 96, col = C.tid & 127, kq = C.tid >> 7; const int cc_ = col < 96 ? col : 95;
        const float* w = A->in[I_WADA] + ((size_t)l * DM + kq * 256) * 6144 + n0 + cc_; const LAS float* s = sl + kq * 256;
        float a0 = 0.f, a1 = 0.f, a2 = 0.f, a3 = 0.f, a4 = 0.f;
        for (int k = 0; k < 256; k += 16) { float wv[16];
#pragma unroll
            for (int j = 0; j < 16; ++j) wv[j] = w[(size_t)(k + j) * 6144];
#pragma unroll
            for (int j = 0; j < 16; ++j) { a0 += s[k + j] * wv[j]; a1 += s[1024 + k + j] * wv[j]; a2 += s[2048 + k + j] * wv[j]; a3 += s[3072 + k + j] * wv[j]; a4 += s[4096 + k + j] * wv[j]; } }
        red[(kq * 5 + 0) * 128 + col] = a0; red[(kq * 5 + 1) * 128 + col] = a1; red[(kq * 5 + 2) * 128 + col] = a2; red[(kq * 5 + 3) * 128 + col] = a3; red[(kq * 5 + 4) * 128 + col] = a4;
        __syncthreads();
        for (int i = C.tid; i < 5 * 128; i += 512) { const int r = i >> 7, cc = i & 127; if (cc >= 96) continue;
            mod[((size_t)l * 5 + r) * 6144 + n0 + cc] = ((red[(0 * 5 + r) * 128 + cc] + red[(1 * 5 + r) * 128 + cc]) + (red[(2 * 5 + r) * 128 + cc] + red[(3 * 5 + r) * 128 + cc])) + A->in[I_BADA][l * 6144 + n0 + cc]; }
        __syncthreads();
    }
}
__device__ __forceinline__ size_t res_row_off(int row, int& mr, bool& isctx) {
    const int b = row / SB, j = row - b * SB; isctx = j >= SEQ; mr = isctx ? 4 : b;
    return isctx ? ((size_t)b * CTXL + (j - SEQ)) * DM : ((size_t)b * SEQ + j) * DM;
}
template <bool F32> __device__ __forceinline__ f32x4 ld4(const void* rowp, int idx) {
    if constexpr (F32) return ((const f32x4*)rowp)[idx];
    else { const u32x2 v = ((const u32x2*)rowp)[idx]; return (f32x4){bflo(v.x), bfhi(v.x), bflo(v.y), bfhi(v.y)}; }
}
template <bool F32> __device__ __forceinline__ void st4(void* rowp, int idx, f32x4 v) {
    if constexpr (F32) ((f32x4*)rowp)[idx] = v; else ((u32x2*)rowp)[idx] = (u32x2){pk2(v.x, v.y), pk2(v.z, v.w)};
}
template <bool ROUTE, bool I8OUT, bool SRC_F32>
__device__ __forceinline__ void norm_phase(const Ctx& C, const void* lat, const void* ctx, const float* gain, const float* modl, int shift_off, int scale_off, bool with_ctx, const float* wr, bf16_t* ctx_copy = nullptr, int nparts = 0) {
    bf16_t* H = (bf16_t*)(C.ws + WS_H);
    LAS float* wrl = (LAS float*)C.lds;
    LAS int* le = (LAS int*)(C.lds + 32768);
    int* RE = (int*)(C.ws + WS_META + MT_RE); float* RW = (float*)(C.ws + WS_META + MT_RW); int* LR = (int*)(C.ws + WS_META + MT_LR); int* BC = (int*)(C.ws + WS_META + MT_BC);
    if (ROUTE) { for (int i = C.tid; i < 8192; i += 512) wrl[i] = wr[i]; __syncthreads(); }
    f32x4 wreg[4][8];
    if (ROUTE) {
#pragma unroll
        for (int j = 0; j < 4; ++j)
#pragma unroll
            for (int q = 0; q < 8; ++q) wreg[j][q] = *(const LAS f32x4*)(wrl + (4 * C.lane + 256 * j) * 8 + 4 * q); }
    const int chunk = TT / 256, row0 = blockIdx.x * chunk;
    for (int rr = C.wave; rr < chunk; rr += 8) {
        const int row = row0 + rr; int mr; bool isctx; const size_t ro = res_row_off(row, mr, isctx);
        const unsigned char* xr = (const unsigned char*)(isctx ? ctx : lat) + ro * (SRC_F32 ? 4 : 2);
        if (isctx && !with_ctx) { if (ROUTE && C.lane == 0) { le[rr * 2] = -1; le[rr * 2 + 1] = -1; RE[row * 2] = -1; RE[row * 2 + 1] = -1; } continue; }
        f32x4 v[4]; float ss = 0.f;
#pragma unroll
        for (int j = 0; j < 4; ++j) { v[j] = ld4<SRC_F32>(xr, C.lane + 64 * j); ss += (v[j].x * v[j].x + v[j].y * v[j].y) + (v[j].z * v[j].z + v[j].w * v[j].w); }
        if (ctx_copy && isctx) {
            const float* cp = (const float*)(C.ws + WS_CPART) + ro;
            for (int p = 0; p < nparts; ++p) { const f32x4* pv = (const f32x4*)(cp + (size_t)p * NB * CTXL * DM) + C.lane;
#pragma unroll
                for (int j = 0; j < 4; ++j) v[j] = v[j] + pv[64 * j]; }
            ss = 0.f;
#pragma unroll
            for (int j = 0; j < 4; ++j) { st4<false>(ctx_copy + ro, C.lane + 64 * j, v[j]); ss += (v[j].x * v[j].x + v[j].y * v[j].y) + (v[j].z * v[j].z + v[j].w * v[j].w); } }
        const float rinv = rsqrtf(wave_sum(ss) * (1.f / DM) + EPS);
        const f32x4* gv = (const f32x4*)gain + C.lane; const f32x4* shv = (const f32x4*)(modl + (size_t)mr * 6144 + shift_off) + C.lane; const f32x4* scv = (const f32x4*)(modl + (size_t)mr * 6144 + scale_off) + C.lane;
        u32x2* o8 = (u32x2*)(H + (size_t)row * DM) + C.lane;
        unsigned* o4 = (unsigned*)((signed char*)H + (size_t)row * DM) + C.lane;
        f32x4 hq[4]; float amax = 0.f;
        float lg[8];
        if (ROUTE) {
#pragma unroll
            for (int e = 0; e < 8; ++e) lg[e] = 0.f; }
#pragma unroll
        for (int j = 0; j < 4; ++j) { const f32x4 g = gv[64 * j], sh = shv[64 * j], sc = scv[64 * j];
            const f32x4 y = (v[j] * rinv) * g; const f32x4 h = y * (sc + 1.f) + sh;
            if (I8OUT) { hq[j] = h; amax = fmaxf(fmaxf(amax, fmaxf(fabsf(h.x), fabsf(h.y))), fmaxf(fabsf(h.z), fabsf(h.w))); } else o8[64 * j] = (u32x2){pk2(h.x, h.y), pk2(h.z, h.w)};
            if (ROUTE) {
#pragma unroll
                for (int e = 0; e < 8; ++e) lg[e] += (h.x * wreg[j][e >> 2][e & 3] + h.y * wreg[j][2 + (e >> 2)][e & 3]) + (h.z * wreg[j][4 + (e >> 2)][e & 3] + h.w * wreg[j][6 + (e >> 2)][e & 3]); } }
        if (I8OUT) {
#pragma unroll
            for (int o = 1; o < 64; o <<= 1) amax = fmaxf(amax, __shfl_xor(amax, o));
            const float inv = amax > 0.f ? 127.f / amax : 0.f;
            if (C.lane == 0) ((float*)(C.ws + WS_META + MT_SH))[row] = amax * (1.f / 127.f);
#pragma unroll
            for (int j = 0; j < 4; ++j) { const int a = (int)rintf(hq[j].x * inv), b = (int)rintf(hq[j].y * inv), c = (int)rintf(hq[j].z * inv), d = (int)rintf(hq[j].w * inv);
                o4[64 * j] = (unsigned)(a & 255) | ((unsigned)(b & 255) << 8) | ((unsigned)(c & 255) << 16) | ((unsigned)(d & 255) << 24); } }
        if (ROUTE) {
#pragma unroll
            for (int e = 0; e < 8; ++e) lg[e] = wave_sum(lg[e]);
            int e1 = 0; float l1 = lg[0];
#pragma unroll
            for (int e = 1; e < 8; ++e) if (lg[e] > l1) { l1 = lg[e]; e1 = e; }
            int e2 = -1; float l2 = -3.0e38f;
#pragma unroll
            for (int e = 0; e < 8; ++e) if (e != e1 && lg[e] > l2) { l2 = lg[e]; e2 = e; }
            if (C.lane == 0) { const float w2 = 1.f / (1.f + expf(l1 - l2)), w1 = 1.f - w2; le[rr * 2] = e1; le[rr * 2 + 1] = e2; RE[row * 2] = e1; RE[row * 2 + 1] = e2; RW[row * 2] = w1; RW[row * 2 + 1] = w2; }
        }
    }
    if (ROUTE) {
        __syncthreads();
        LAS int* lr = le + 264;
        if (C.tid < 8) { int cnt = 0; for (int i = 0; i < chunk * 2; ++i) if (le[i] == C.tid) lr[i] = cnt++; BC[blockIdx.x * 8 + C.tid] = cnt; }
        __syncthreads();
        for (int i = C.tid; i < chunk * 2; i += 512) LR[row0 * 2 + i] = (le[i] >= 0) ? lr[i] : 0;
        __syncthreads();
    }
}
__device__ __forceinline__ void qkpost_phase(const Ctx& C, const float* qn, const float* kn, bool ctx_q) {
    const bf16_t* P = (const bf16_t*)(C.ws + WS_P); const bf16_t* QR = (const bf16_t*)(C.ws + WS_QRAW); const bf16_t* KVR = (const bf16_t*)(C.ws + WS_KVRAW);
    unsigned char* Q = C.ws + WS_Q; unsigned char* K = C.ws + WS_K; unsigned char* V = C.ws + WS_V;
    const int lane = C.lane, h = lane >> 3, s = lane & 7;
    const int rb1 = (s < 4) ? 64 : 80, i0 = (2 * s) & 7;
    float gq[12], gk[12];
#pragma unroll
    for (int j = 0; j < 8; ++j) { gq[j] = qn[8 * s + j]; gk[j] = kn[8 * s + j]; }
    gq[8] = qn[rb1 + i0]; gq[9] = qn[rb1 + i0 + 1]; gq[10] = qn[rb1 + 8 + i0]; gq[11] = qn[rb1 + 8 + i0 + 1];
    gk[8] = kn[rb1 + i0]; gk[9] = kn[rb1 + i0 + 1]; gk[10] = kn[rb1 + 8 + i0]; gk[11] = kn[rb1 + 8 + i0 + 1];
    const float if0 = powf(10000.f, -(float)i0 * 0.125f), if1 = powf(10000.f, -(float)(i0 + 1) * 0.125f);
    for (int grp = C.gw; grp < TT / 4; grp += C.NGW) {
      const int row0 = grp * 4, b = row0 / SB, j0 = row0 - b * SB; const bool isctx = j0 >= SEQ;
      float vprev[8]; int vacc[8];
#pragma unroll
      for (int i = 0; i < 8; ++i) { vprev[i] = 0.f; vacc[i] = 0; }
#pragma unroll
      for (int rr = 0; rr < 4; ++rr) {
        const int row = row0 + rr, j = j0 + rr;
        const bf16_t* pr = P + (size_t)row * INW;
        const u32x2 cq = *(const u32x2*)(pr + 4 * lane), ckv = *(const u32x2*)(pr + 256 + 4 * lane);
        float sq = bflo(cq.x) * bflo(cq.x) + bfhi(cq.x) * bfhi(cq.x) + bflo(cq.y) * bflo(cq.y) + bfhi(cq.y) * bfhi(cq.y);
        float sk = bflo(ckv.x) * bflo(ckv.x) + bfhi(ckv.x) * bfhi(ckv.x) + bflo(ckv.y) * bflo(ckv.y) + bfhi(ckv.y) * bfhi(ckv.y);
        const float aq = rsqrtf(wave_sum(sq) * (1.f / 256.f) + EPS), akv = rsqrtf(wave_sum(sk) * (1.f / 256.f) + EPS);
        float cs0 = 1.f, sn0 = 0.f, cs1 = 1.f, sn1 = 0.f;
        if (!isctx) { const float pos = (s < 4) ? (float)(j >> 6) : (float)(j & 63); sincosf(pos * if0, &sn0, &cs0); sincosf(pos * if1, &sn1, &cs1); }
        { const bf16_t* kvr = KVR + (size_t)row * 1024 + h * 128;
          const u32x4 kn8 = *(const u32x4*)(kvr + 8 * s), vv8 = *(const u32x4*)(kvr + 64 + 8 * s);
          const unsigned pe1 = *(const unsigned*)(pr + 512 + (rb1 - 64) + i0), pe2 = *(const unsigned*)(pr + 512 + (rb1 - 64) + 8 + i0);
          float x[12]; x[0] = bflo(kn8.x) * akv; x[1] = bfhi(kn8.x) * akv; x[2] = bflo(kn8.y) * akv; x[3] = bfhi(kn8.y) * akv; x[4] = bflo(kn8.z) * akv; x[5] = bfhi(kn8.z) * akv; x[6] = bflo(kn8.w) * akv; x[7] = bfhi(kn8.w) * akv;
          x[8] = bflo(pe1); x[9] = bfhi(pe1); x[10] = bflo(pe2); x[11] = bfhi(pe2);
          float ss = 0.f;
#pragma unroll
          for (int i = 0; i < 12; ++i) ss += x[i] * x[i];
          ss += __shfl_xor(ss, 1); ss += __shfl_xor(ss, 2); ss += __shfl_xor(ss, 4);
          const float rn = rsqrtf(ss * (1.f / 96.f) + EPS);
#pragma unroll
          for (int i = 0; i < 12; ++i) x[i] = x[i] * rn * gk[i];
          const float r0 = x[8] * cs0 - x[10] * sn0, r1 = x[9] * cs1 - x[11] * sn1, r2 = x[8] * sn0 + x[10] * cs0, r3 = x[9] * sn1 + x[11] * cs1;
          unsigned char* ko = K + (size_t)row * 768 + h * 96;
          *(u32x2*)(ko + 8 * s) = (u32x2){pk4f8(x[0], x[1], x[2], x[3]), pk4f8(x[4], x[5], x[6], x[7])};
          *(unsigned short*)(ko + rb1 + i0) = (unsigned short)pk4f8(r0, r1, 0.f, 0.f); *(unsigned short*)(ko + rb1 + 8 + i0) = (unsigned short)pk4f8(r2, r3, 0.f, 0.f);
          const float vf[8] = {c448(bflo(vv8.x) * akv), c448(bfhi(vv8.x) * akv), c448(bflo(vv8.y) * akv), c448(bfhi(vv8.y) * akv), c448(bflo(vv8.z) * akv), c448(bfhi(vv8.z) * akv), c448(bflo(vv8.w) * akv), c448(bfhi(vv8.w) * akv)};
#pragma unroll
          for (int i = 0; i < 8; ++i) { if (rr == 1) vacc[i] = __builtin_amdgcn_cvt_pk_fp8_f32(vprev[i], vf[i], vacc[i], false); else if (rr == 3) vacc[i] = __builtin_amdgcn_cvt_pk_fp8_f32(vprev[i], vf[i], vacc[i], true); else vprev[i] = vf[i]; } }
        if (!isctx || ctx_q) {
          const bf16_t* qr = QR + (size_t)row * 768 + h * 96;
          const u32x4 q8 = *(const u32x4*)(qr + 8 * s); const unsigned q1 = *(const unsigned*)(qr + rb1 + i0), q2 = *(const unsigned*)(qr + rb1 + 8 + i0);
          float x[12]; x[0] = bflo(q8.x); x[1] = bfhi(q8.x); x[2] = bflo(q8.y); x[3] = bfhi(q8.y); x[4] = bflo(q8.z); x[5] = bfhi(q8.z); x[6] = bflo(q8.w); x[7] = bfhi(q8.w);
          x[8] = bflo(q1); x[9] = bfhi(q1); x[10] = bflo(q2); x[11] = bfhi(q2);
          float ss = 0.f;
#pragma unroll
          for (int i = 0; i < 12; ++i) { x[i] *= aq; ss += x[i] * x[i]; }
          ss += __shfl_xor(ss, 1); ss += __shfl_xor(ss, 2); ss += __shfl_xor(ss, 4);
          const float rn = rsqrtf(ss * (1.f / 96.f) + EPS) * QSCALE;
#pragma unroll
          for (int i = 0; i < 12; ++i) x[i] = x[i] * rn * gq[i];
          const float r0 = x[8] * cs0 - x[10] * sn0, r1 = x[9] * cs1 - x[11] * sn1, r2 = x[8] * sn0 + x[10] * cs0, r3 = x[9] * sn1 + x[11] * cs1;
          unsigned char* qo = Q + (size_t)row * 768 + h * 96;
          *(u32x2*)(qo + 8 * s) = (u32x2){pk4f8(x[0], x[1], x[2], x[3]), pk4f8(x[4], x[5], x[6], x[7])};
          *(unsigned short*)(qo + rb1 + i0) = (unsigned short)pk4f8(r0, r1, 0.f, 0.f); *(unsigned short*)(qo + rb1 + 8 + i0) = (unsigned short)pk4f8(r2, r3, 0.f, 0.f); }
      }
      unsigned char* vo = V + ((size_t)(b * NH + h) * (SB / 64) + (j0 >> 6)) * 4096 + (8 * s) * 64 + (j0 & 63);
#pragma unroll
      for (int i = 0; i < 8; ++i) *(unsigned*)(vo + i * 64) = (unsigned)vacc[i];
    }
}
__device__ __forceinline__ void mixnorm_phase(const Ctx& C, const float* ga, const float* gf, bool with_ctx) {
    const bf16_t* AT = (const bf16_t*)(C.ws + WS_ATT); const bf16_t* FO = (const bf16_t*)(C.ws + WS_FOUR); signed char* H8 = (signed char*)(C.ws + WS_H); float* SH = (float*)(C.ws + WS_META + MT_SH);
    const int lane = C.lane;
    const f32x4 ga0 = *(const f32x4*)(ga + 8 * lane), ga1 = *(const f32x4*)(ga + 8 * lane + 4), gf0 = *(const f32x4*)(gf + 8 * lane), gf1 = *(const f32x4*)(gf + 8 * lane + 4);
    for (int row = C.gw; row < TT; row += C.NGW) {
        if (!with_ctx && (row % SB) >= SEQ) continue;
        const u32x4 a = *(const u32x4*)(AT + (size_t)row * 512 + 8 * lane), f = *(const u32x4*)(FO + (size_t)row * 512 + 8 * lane);
        float xa[8] = {bflo(a.x), bfhi(a.x), bflo(a.y), bfhi(a.y), bflo(a.z), bfhi(a.z), bflo(a.w), bfhi(a.w)}, xf[8] = {bflo(f.x), bfhi(f.x), bflo(f.y), bfhi(f.y), bflo(f.z), bfhi(f.z), bflo(f.w), bfhi(f.w)};
        float sa = 0.f, sf = 0.f;
#pragma unroll
        for (int i = 0; i < 8; ++i) { sa += xa[i] * xa[i]; sf += xf[i] * xf[i]; }
        const float ra = rsqrtf(wave_sum(sa) * (1.f / 512.f) + EPS), rf = rsqrtf(wave_sum(sf) * (1.f / 512.f) + EPS);
        float amax = 0.f;
#pragma unroll
        for (int i = 0; i < 4; ++i) { xa[i] = xa[i] * ra * ga0[i]; xa[4 + i] = xa[4 + i] * ra * ga1[i]; xf[i] = xf[i] * rf * gf0[i]; xf[4 + i] = xf[4 + i] * rf * gf1[i]; }
#pragma unroll
        for (int i = 0; i < 8; ++i) amax = fmaxf(amax, fmaxf(fabsf(xa[i]), fabsf(xf[i])));
#pragma unroll
        for (int o = 1; o < 64; o <<= 1) amax = fmaxf(amax, __shfl_xor(amax, o));
        const float inv = amax > 0.f ? 127.f / amax : 0.f;
        if (lane == 0) SH[row] = amax * (1.f / 127.f);
        unsigned qa[2], qf[2];
#pragma unroll
        for (int i = 0; i < 2; ++i) { qa[i] = ((unsigned)((int)rintf(xa[4 * i] * inv) & 255)) | ((unsigned)((int)rintf(xa[4 * i + 1] * inv) & 255) << 8) | ((unsigned)((int)rintf(xa[4 * i + 2] * inv) & 255) << 16) | ((unsigned)((int)rintf(xa[4 * i + 3] * inv) & 255) << 24);
            qf[i] = ((unsigned)((int)rintf(xf[4 * i] * inv) & 255)) | ((unsigned)((int)rintf(xf[4 * i + 1] * inv) & 255) << 8) | ((unsigned)((int)rintf(xf[4 * i + 2] * inv) & 255) << 16) | ((unsigned)((int)rintf(xf[4 * i + 3] * inv) & 255) << 24); }
        signed char* o = H8 + (size_t)row * DM + 8 * lane;
        *(u32x2*)o = (u32x2){qa[0], qa[1]}; *(u32x2*)(o + 512) = (u32x2){qf[0], qf[1]};
    }
}
__device__ __forceinline__ void moe_assign_phase(const Ctx& C) {
    const int* RE = (const int*)(C.ws + WS_META + MT_RE); const int* LR = (const int*)(C.ws + WS_META + MT_LR); const int* BC = (const int*)(C.ws + WS_META + MT_BC);
    int* TS = (int*)(C.ws + WS_META + MT_TS); int* TE = (int*)(C.ws + WS_META + MT_TE); int* NTP = (int*)(C.ws + WS_META + MT_NT);
    LAS int* bc = (LAS int*)C.lds; LAS int* base = bc + 2048;
    for (int i = C.tid; i < 2048; i += 512) bc[i] = BC[i];
    __syncthreads();
    if (C.tid < 8) { int pre = 0, tot = 0; for (int b = 0; b < 256; ++b) { const int v = bc[b * 8 + C.tid]; if (b < (int)blockIdx.x) pre += v; tot += v; } base[C.tid] = pre; base[8 + C.tid] = tot; }
    __syncthreads();
    if (C.tid == 0) { int run = 0; for (int e = 0; e < 8; ++e) { const int tot = base[8 + e], tiles = (tot + 255) >> 8;
            if (blockIdx.x == 0) for (int t = 0; t < tiles; ++t) TE[(run >> 8) + t] = e;
            base[e] += run; run += tiles << 8; }
        if (blockIdx.x == 0) NTP[0] = run >> 8; }
    __syncthreads();
    const bf16_t* H = (const bf16_t*)(C.ws + WS_H); bf16_t* AM = (bf16_t*)(C.ws + WS_AMOE);
    const int chunk = TT / 256, row0 = blockIdx.x * chunk;
    for (int rr = C.wave; rr < chunk; rr += 8) { const int row = row0 + rr;
#pragma unroll
        for (int k = 0; k < 2; ++k) { const int e = RE[row * 2 + k]; if (e < 0) { if (C.lane == 0) TS[row * 2 + k] = -1; continue; }
            const int slot = base[e] + LR[row * 2 + k]; if (C.lane == 0) TS[row * 2 + k] = slot;
            const u32x4* src = (const u32x4*)((const signed char*)H + (size_t)row * DM) + C.lane; u32x4* dst = (u32x4*)((signed char*)AM + (size_t)slot * DM) + C.lane;
            dst[0] = src[0]; if (C.lane == 0) ((float*)(C.ws + WS_META + MT_SA))[slot] = ((const float*)(C.ws + WS_META + MT_SH))[row]; } }
}
template <bool FUSE_N1, bool DST_F32> __device__ __forceinline__ void moe_combine_phase(const Ctx& C, bf16_t* lat, bf16_t* ctx, float* out32, const float* modl, int gate_off, const float* gain_n = nullptr, const float* modn = nullptr) {
    const int* TS = (const int*)(C.ws + WS_META + MT_TS); const float* RW = (const float*)(C.ws + WS_META + MT_RW); const bf16_t* Y = (const bf16_t*)(C.ws + WS_Y);
    for (int row = C.gw; row < TT; row += C.NGW) {
        const int s0 = TS[row * 2], s1 = TS[row * 2 + 1]; if (s0 < 0) continue;
        int mr; bool isctx; const size_t ro = res_row_off(row, mr, isctx); bf16_t* xr = (isctx ? ctx : lat) + ro;
        const float w0 = RW[row * 2] * DOWN_OSCALE, w1 = RW[row * 2 + 1] * DOWN_OSCALE;
        const f32x4* gv = (const f32x4*)(modl + (size_t)mr * 6144 + gate_off) + C.lane;
        const u32x2* y0 = (const u32x2*)(Y + (size_t)s0 * DM) + C.lane; const u32x2* y1 = (const u32x2*)(Y + (size_t)s1 * DM) + C.lane;
        f32x4 xs[4]; float ss = 0.f;
#pragma unroll
        for (int j = 0; j < 4; ++j) { const u32x2 a = y0[64 * j], b = y1[64 * j]; const f32x4 g = gv[64 * j]; f32x4 x = ld4<false>(xr, C.lane + 64 * j);
            x.x += g.x * (w0 * bflo(a.x) + w1 * bflo(b.x)); x.y += g.y * (w0 * bfhi(a.x) + w1 * bfhi(b.x)); x.z += g.z * (w0 * bflo(a.y) + w1 * bflo(b.y)); x.w += g.w * (w0 * bfhi(a.y) + w1 * bfhi(b.y));
            if constexpr (DST_F32) st4<true>(out32 + ro, C.lane + 64 * j, x); else st4<false>(xr, C.lane + 64 * j, x);
            xs[j] = x; ss += (x.x * x.x + x.y * x.y) + (x.z * x.z + x.w * x.w); }
        if constexpr (FUSE_N1) {
            const float rinv = rsqrtf(wave_sum(ss) * (1.f / DM) + EPS);
            const f32x4* gn = (const f32x4*)gain_n + C.lane; const f32x4* shv = (const f32x4*)(modn + (size_t)mr * 6144) + C.lane; const f32x4* scv = (const f32x4*)(modn + (size_t)mr * 6144 + 1024) + C.lane;
            float amax = 0.f;
#pragma unroll
            for (int j = 0; j < 4; ++j) { const f32x4 h = ((xs[j] * rinv) * gn[64 * j]) * (scv[64 * j] + 1.f) + shv[64 * j]; xs[j] = h; amax = fmaxf(fmaxf(amax, fmaxf(fabsf(h.x), fabsf(h.y))), fmaxf(fabsf(h.z), fabsf(h.w))); }
#pragma unroll
            for (int o = 1; o < 64; o <<= 1) amax = fmaxf(amax, __shfl_xor(amax, o));
            const float inv = amax > 0.f ? 127.f / amax : 0.f;
            if (C.lane == 0) ((float*)(C.ws + WS_META + MT_SH))[row] = amax * (1.f / 127.f);
            unsigned* o4 = (unsigned*)((signed char*)(C.ws + WS_H) + (size_t)row * DM) + C.lane;
#pragma unroll
            for (int j = 0; j < 4; ++j) { const int a = (int)rintf(xs[j].x * inv), b = (int)rintf(xs[j].y * inv), c = (int)rintf(xs[j].z * inv), d = (int)rintf(xs[j].w * inv);
                o4[64 * j] = (unsigned)(a & 255) | ((unsigned)(b & 255) << 8) | ((unsigned)(c & 255) << 16) | ((unsigned)(d & 255) << 24); } }
    }
}
#ifndef R_ATT
#define R_ATT 1
#endif
#ifndef R_MOE
#define R_MOE 1
#endif
#ifndef R_PROJ
#define R_PROJ 1
#endif
#ifndef R_GU
#define R_GU 1
#endif
#ifndef R_BAR
#define R_BAR 1
#endif
#ifndef R_N1
#define R_N1 1
#endif
#ifndef R_F1
#define R_F1 1
#endif
#ifndef R_QK
#define R_QK 1
#endif
#ifndef R_F2
#define R_F2 1
#endif
#ifndef R_MX
#define R_MX 1
#endif
#ifndef R_CF
#define R_CF 1
#endif
#ifndef R_CMB
#define R_CMB 1
#endif
#ifndef R_MISC
#define R_MISC 1
#endif
#ifndef R_PRO
#define R_PRO 1
#endif
#ifndef R_N2
#define R_N2 1
#endif
#ifndef R_ASG
#define R_ASG 1
#endif
#ifndef R_CV3
#define R_CV3 1
#endif

#define GRID_BAR() do { XcdBarrier b_; b_.bar = (unsigned*)(KA()->ws + WS_CTL); b_.x = xb_xcc_id(); b_.st = (volatile LAS unsigned*)(lds + MISC_OFF) + 8; for (int rb_ = 0; rb_ < R_BAR; ++rb_) xcd_barrier(b_); } while (0)
#define PHASE_CTX() Ctx C; { KArgs* ka_ = KA(); C.out = ka_->out; C.ws = ka_->ws; C.lds = lds; C.tid = otid(); C.lane = C.tid & 63; C.wave = __builtin_amdgcn_readfirstlane(C.tid >> 6); \
        C.G = gridDim.x; const int bx_ = blockIdx.x; C.vcu = (C.G % 8 == 0) ? (bx_ % 8) * (C.G / 8) + bx_ / 8 : bx_; C.gw = C.vcu * 8 + C.wave; C.NGW = C.G * 8; } \
        unsigned char* ws = C.ws; float* mod = (float*)(ws + WS_MOD); bf16_t* ctxs = (bf16_t*)(ws + WS_XCB); bf16_t* xb = (bf16_t*)(ws + WS_XB); bf16_t* H = (bf16_t*)(ws + WS_H); bf16_t* P = (bf16_t*)(ws + WS_P); const int G = C.G, bx = blockIdx.x; \
        const float* modl = mod + (size_t)l * 5 * 6144; const void* lat_res = (l == 0) ? (const void*)KA()->in[I_X] : (const void*)xb; const void* ctx_res = (l == 0) ? (const void*)KA()->in[I_CTX] : (const void*)ctxs; \
        (void)mod; (void)ctxs; (void)xb; (void)H; (void)P; (void)G; (void)bx; (void)modl; (void)lat_res; (void)ctx_res;
template <int l> __device__ __forceinline__ void layer_body(LAS unsigned char* lds) {
        const bool upd = l < DEPTH - 1;
        if (l != 2) {
        for (int rep_ = 0; rep_ < R_N1; ++rep_) { PHASE_CTX(); norm_phase<false, true, l == 0>(C, lat_res, ctx_res, KA()->in[I_NORM1] + l * DM, modl, 0, 1024, true, nullptr, (l == 0 || (l & 1)) ? ctxs : nullptr, (l & 1) ? 3 : 0); }
        GRID_BAR();
        }
        for (int rep_ = 0; rep_ < R_PROJ; ++rep_) { PHASE_CTX(); pg8::DenseOrder S{(const char*)H, (const char*)(ws + WS_WIN) + (size_t)l * 1280 * DM, (size_t)256 * DM, (size_t)256 * DM, MT, 5, G, bx, 0};
          pg8::EpiBf16<1> E{P, (const float*)(ws + WS_META + MT_SH), (const float*)(ws + WS_SCL + SCL_SWI) + l * 1280, INW, INW};
          pg8::gemm_phase<pg8::EpiBf16<1>, pg8::DenseOrder, true, true>(lds, DM / 2, DM / 2, DM / 2, S, E); }
        GRID_BAR();
        for (int rep_ = 0; rep_ < R_PROJ; ++rep_) { PHASE_CTX(); pg8::DenseOrder S{(const char*)P, (const char*)((bf16_t*)(ws + WS_WUQ) + (size_t)l * 768 * 256), (size_t)256 * INW * 2, (size_t)256 * 256 * 2, MT, 3, G, bx, 0};
          pg8::EpiBf16<0> E{(bf16_t*)(ws + WS_QRAW), nullptr, nullptr, 768, 768};
          int kk_ = 256; asm volatile("" : "+s"(kk_));
          pg8::gemm_phase<pg8::EpiBf16<0>, pg8::DenseOrder, true, true>(lds, kk_, INW, 256, S, E); }
        for (int rep_ = 0; rep_ < R_PROJ; ++rep_) { PHASE_CTX(); pg8::DenseOrder S{(const char*)(P + 256), (const char*)((bf16_t*)(ws + WS_WUKV) + (size_t)l * 1024 * 256), (size_t)256 * INW * 2, (size_t)256 * 256 * 2, MT, 4, G, (bx + G - 144) % G, 0};
          pg8::EpiBf16<0> E{(bf16_t*)(ws + WS_KVRAW), nullptr, nullptr, 1024, 1024};
          int kk_ = 256; asm volatile("" : "+s"(kk_));
          pg8::gemm_phase<pg8::EpiBf16<0>, pg8::DenseOrder, true, true>(lds, kk_, INW, 256, S, E); }
        for (int rep_ = 0; rep_ < R_F1; ++rep_) { PHASE_CTX(); fft::fft1_phase(P, (bf16_t*)(ws + WS_MID), lds, C.vcu, G); }
        if (upd) for (int rep_ = 0; rep_ < R_CF; ++rep_) { PHASE_CTX(); fft::ctxfour_phase(P, (bf16_t*)(ws + WS_FOUR), lds, C.vcu, G); }
        GRID_BAR();
        for (int rep_ = 0; rep_ < R_QK; ++rep_) { PHASE_CTX(); qkpost_phase(C, KA()->in[I_QN] + l * QKD, KA()->in[I_KN] + l * QKD, upd); }
        for (int rep_ = 0; rep_ < R_F2; ++rep_) { PHASE_CTX(); fft::fft2_phase((const bf16_t*)(ws + WS_MID), (bf16_t*)(ws + WS_FOUR), lds, C.vcu, G); }
        GRID_BAR();
        for (int rep_ = 0; rep_ < R_ATT; ++rep_) { PHASE_CTX(); const unsigned char* Q = ws + WS_Q; const unsigned char* K = ws + WS_K; const unsigned char* V = ws + WS_V; bf16_t* AT = (bf16_t*)(ws + WS_ATT);
          for (int U = C.vcu; U < 512; U += G) { const int i = U >> 8, v = U & 255, bh = v >> 3, qb = (v & 7) + 8 * i, b = bh >> 3, h = bh & 7;
              att::attn_unit(Q + ((size_t)b * SB + qb * 512) * 768 + h * 96, K + (size_t)b * SB * 768 + h * 96, V + (size_t)bh * (SB / 64) * 4096, AT + ((size_t)b * SB + qb * 512) * 512 + h * 64, SB / 64, 8, lds); }
          if (upd) for (int U = C.vcu; U < 256; U += G) { if (U & 7) continue; const int bh = U >> 3, b = bh >> 3, h = bh & 7; const size_t r0 = (size_t)b * SB + SEQ;
              att::attn_unit(Q + r0 * 768 + h * 96, K + r0 * 768 + h * 96, V + ((size_t)bh * (SB / 64) + SEQ / 64) * 4096, AT + r0 * 512 + h * 64, CTXL / 64, 4, lds); } }
        GRID_BAR();
        for (int rep_ = 0; rep_ < R_MX; ++rep_) { PHASE_CTX(); mixnorm_phase(C, KA()->in[I_ONA] + l * AW, KA()->in[I_ONF] + l * FW, upd); }
        GRID_BAR();
        { PHASE_CTX(); pg8::DenseOrder S{(const char*)H, (const char*)(ws + WS_WOUT) + (size_t)l * DM * DM, (size_t)256 * DM, (size_t)256 * DM, 128, 4, G, bx, 1};
          pg8::EpiResid<1, l == 0> E{lat_res, xb, ctx_res, ctxs, modl + 2048, (const float*)(ws + WS_META + MT_SH), (const float*)(ws + WS_SCL + SCL_SWO) + l * DM, 1.f / 127.f};
          pg8::gemm_phase<pg8::EpiResid<1, l == 0>, pg8::DenseOrder, true, true>(lds, DM / 2, DM / 2, DM / 2, S, E); }
#define CTX_WOUT(kp) { PHASE_CTX();       \
          pg8::CtxOrder S{(const char*)H + (kp) * 512, (const char*)(ws + WS_WOUT) + (size_t)l * DM * DM + (kp) * 512, (size_t)256 * DM, (size_t)256 * DM, G, (bx + G - 16 * (kp)) % G}; \
          pg8::EpiCtxPart<1> E{(float*)(ws + WS_CPART) + (size_t)(kp) * NB * CTXL * DM, modl + 2048, (const float*)(ws + WS_META + MT_SH), (const float*)(ws + WS_SCL + SCL_SWO) + l * DM, 1.f / 127.f, 0}; \
          int kk_ = 256; asm volatile("" : "+s"(kk_));     \
          pg8::gemm_phase<pg8::EpiCtxPart<1>, pg8::CtxOrder, true, true>(lds, kk_, DM / 2, DM / 2, S, E); }
        if (upd) { CTX_WOUT(0) CTX_WOUT(1) }
#undef CTX_WOUT
        GRID_BAR();
        if ((l & 1) == 0) {
            for (int rep_ = 0; rep_ < R_N2; ++rep_) { PHASE_CTX(); norm_phase<false, true, false>(C, xb, ctxs, KA()->in[I_NORM2] + l * DM, modl, 3072, 4096, upd, nullptr, upd ? ctxs : nullptr, 2); }
            GRID_BAR();
            for (int rep_ = 0; rep_ < R_GU; ++rep_) { PHASE_CTX(); pg8::DenseOrder S{(const char*)H, (const char*)(ws + WS_WGU) + (size_t)(l >> 1) * 5632 * DM, (size_t)256 * DM, (size_t)256 * DM, upd ? MT : 128, 22, G, bx, upd ? 0 : 1};
              pg8::EpiSwigluI8<true> E{(bf16_t*)(ws + WS_HID), FFN, (const float*)(ws + WS_META + MT_SH), (const float*)(ws + WS_SCL + SCL_SWD) + (l >> 1) * 5632, lds};
              pg8::gemm_phase<pg8::EpiSwigluI8<true>, pg8::DenseOrder, true, true>(lds, DM / 2, DM / 2, DM / 2, S, E); }
#ifdef R_GUX
            { PHASE_CTX(); pg8::DenseOrder S{(const char*)H, (const char*)(ws + WS_WGU) + (size_t)(l >> 1) * 5632 * DM, (size_t)256 * DM, (size_t)256 * DM, upd ? MT : 128, 22, G, bx, upd ? 0 : 1};
#if R_GUX == 0
              pg8::EpiSwigluI8<true> E{(bf16_t*)(ws + WS_Y), FFN, (const float*)(ws + WS_META + MT_SH), (const float*)(ws + WS_SCL + SCL_SWD) + (l >> 1) * 5632, lds};
              pg8::gemm_phase<pg8::EpiSwigluI8<true>, pg8::DenseOrder, true, true>(lds, DM / 2, DM / 2, DM / 2, S, E); }
#else
              pg8::EpiNullI8 E{(unsigned*)(ws + WS_Y)};
              pg8::gemm_phase<pg8::EpiNullI8, pg8::DenseOrder, true, true>(lds, DM / 2, DM / 2, DM / 2, S, E); }
#endif
#endif
            GRID_BAR();
            { PHASE_CTX(); pg8::DenseOrder S{(const char*)(ws + WS_HID), (const char*)(ws + WS_WD) + (size_t)(l >> 1) * DM * FFN, (size_t)256 * FFN, (size_t)256 * FFN, 128, 4, G, bx, 1};
              pg8::EpiResid<2, false> E{xb, xb, ctxs, ctxs, modl + 5120, nullptr, nullptr, DOWN_OSCALE};
              pg8::gemm_phase<pg8::EpiResid<2, false>, pg8::DenseOrder, true, true>(lds, FFN / 2, FFN / 2, FFN / 2, S, E); }
#define CTX_DOWN(kp) { PHASE_CTX();     \
              const int kb = (kp) * 1024, kk = ((kp) < 2) ? 512 : 384; \
              pg8::CtxOrder S{(const char*)(ws + WS_HID) + kb, (const char*)(ws + WS_WD) + (size_t)(l >> 1) * DM * FFN + kb, (size_t)256 * FFN, (size_t)256 * FFN, G, (bx + G - 16 * (kp)) % G}; \
              pg8::EpiCtxPart<2> E{(float*)(ws + WS_CPART) + (size_t)(kp) * NB * CTXL * DM, modl + 5120, nullptr, nullptr, DOWN_OSCALE, 0}; \
              pg8::gemm_phase<pg8::EpiCtxPart<2>, pg8::CtxOrder, true, true>(lds, kk, FFN / 2, FFN / 2, S, E); }
            if (upd) { CTX_DOWN(0) CTX_DOWN(1) CTX_DOWN(2) }
#undef CTX_DOWN
            GRID_BAR();
        } else {
            for (int rep_ = 0; rep_ < R_N2; ++rep_) { PHASE_CTX(); norm_phase<true, true, false>(C, xb, ctxs, KA()->in[I_NORM2] + l * DM, modl, 3072, 4096, upd, KA()->in[I_WR] + (size_t)(l >> 1) * DM * NE, upd ? ctxs : nullptr, 2); }
            GRID_BAR();
            for (int rep_ = 0; rep_ < R_ASG; ++rep_) { PHASE_CTX(); moe_assign_phase(C); }
            GRID_BAR();
            for (int rep_ = 0; rep_ < R_MOE; ++rep_) {
                { PHASE_CTX(); const int ntiles = __builtin_amdgcn_readfirstlane(*(const int*)(ws + WS_META + MT_NT)); LAS int* TE = (LAS int*)(lds + MISC_OFF + 8192);
                  if (C.tid < MOE_MAX_TILES) TE[C.tid] = ((const int*)(ws + WS_META + MT_TE))[C.tid]; __syncthreads();
                  pg8::MoeOrder S{(const char*)(ws + WS_AMOE), (const char*)(ws + WS_MGU), (size_t)256 * DM, (size_t)256 * DM, (size_t)7168 * DM, TE, 0, ntiles, 28, G, bx, 7168};
                  pg8::EpiSwigluI8<true> E{(bf16_t*)(ws + WS_HMOE), MFF, (const float*)(ws + WS_META + MT_SA), (const float*)(ws + WS_SCL + SCL_SWM) + (size_t)(l >> 1) * 8 * 7168, lds};
                  pg8::gemm_phase<pg8::EpiSwigluI8<true>, pg8::MoeOrder, true, true>(lds, DM / 2, DM / 2, DM / 2, S, E); }
                GRID_BAR();
                { PHASE_CTX(); const int ntiles = __builtin_amdgcn_readfirstlane(*(const int*)(ws + WS_META + MT_NT)); LAS int* TE = (LAS int*)(lds + MISC_OFF + 8192);
                  if (C.tid < MOE_MAX_TILES) TE[C.tid] = ((const int*)(ws + WS_META + MT_TE))[C.tid]; __syncthreads();
                  pg8::MoeOrder S{(const char*)(ws + WS_HMOE), (const char*)(ws + WS_MD), (size_t)256 * MFF, (size_t)256 * MFF, (size_t)DM * MFF, TE, 0, ntiles, 4, G, bx, 0};
                  pg8::EpiBf16<2> E{(bf16_t*)(ws + WS_Y), nullptr, nullptr, DM, DM};
                  pg8::gemm_phase<pg8::EpiBf16<2>, pg8::MoeOrder, true, true>(lds, MFF / 2, MFF / 2, MFF / 2, S, E); }
                GRID_BAR();
            }
            { PHASE_CTX();
              if (l == 1) { moe_combine_phase<true, false>(C, xb, ctxs, nullptr, modl, 5120, KA()->in[I_NORM1] + (l + 1) * DM, mod + (size_t)(l + 1) * 5 * 6144); conv_moe(C, 1); }
              else moe_combine_phase<false, true>(C, xb, ctxs, C.out, modl, 5120); }
            GRID_BAR();
        }
}

__global__ void __launch_bounds__(512, 2) fwd_kernel(Args args) {
    extern __shared__ __attribute__((aligned(16))) unsigned char lds_raw[];
    LAS unsigned char* lds = (LAS unsigned char*)lds_raw;
    volatile LAS unsigned* MISC = (volatile LAS unsigned*)(lds + MISC_OFF);
    if (threadIdx.x < 32) MISC[threadIdx.x] = 0u;
    __syncthreads();
    (void)xcd_barrier_post((unsigned*)(args.ws + WS_CTL), MISC + 8);

    { const int l = 0; PHASE_CTX(); ada_phase(C); conv_dense_weights(C); conv_gu(C); conv_moe(C, 0); }
    GRID_BAR();

    layer_body<0>(lds); layer_body<1>(lds); layer_body<2>(lds); layer_body<3>(lds);
}

extern "C" void kernel_launch(void* const* d_in, const int* in_sizes, int n_in, void* d_out, int out_size, void* d_ws, size_t ws_size, hipStream_t stream) {
    static int grid = 0;
    if (grid == 0) {
        if (n_in != 25 || out_size != NB * SEQ * DM || ws_size < WS_END) { fprintf(stderr, "kernel_launch: unexpected shapes (n_in %d, out %d, ws %zu < %zu)\n", n_in, out_size, ws_size, (size_t)WS_END); grid = -1; return; }
        int dev = 0, cus = 0, per_cu = 0;
        if (hipGetDevice(&dev) != hipSuccess || hipDeviceGetAttribute(&cus, hipDeviceAttributeMultiprocessorCount, dev) != hipSuccess) { grid = -1; return; }
        if (hipFuncSetAttribute((const void*)fwd_kernel, hipFuncAttributeMaxDynamicSharedMemorySize, LDS_BYTES) != hipSuccess) { fprintf(stderr, "kernel_launch: hipFuncSetAttribute failed\n"); grid = -1; return; }
        if (hipOccupancyMaxActiveBlocksPerMultiprocessor(&per_cu, (const void*)fwd_kernel, 512, LDS_BYTES) != hipSuccess || per_cu < 1) { fprintf(stderr, "kernel_launch: occupancy query says %d\n", per_cu); }
        (void)hipGetLastError();
        grid = (cus >= 256) ? 256 : -1;
        if (grid < 0) fprintf(stderr, "kernel_launch: needs a 256-CU device (got %d)\n", cus);
    }
    if (grid < 0) return;
    if (hipMemsetAsync((char*)d_ws + WS_CTL, 0, CTL_ZERO_BYTES, stream) != hipSuccess) return;
    Args a{};
    for (int i = 0; i < 25; ++i) a.in[i] = (const float*)d_in[i];
    a.out = (float*)d_out; a.ws = (unsigned char*)d_ws; a.pad0 = 0; a.pad1 = 0;
    hipLaunchKernelGGL(fwd_kernel, dim3(grid), dim3(512), LDS_BYTES, stream, a);
}
```
